# Optimizing an MI355X kernel written in HIP

```python
import jax, jax.numpy as jnp
from jax import lax
import numpy as np

D_MODEL = 2048
BATCH = 32
SEQ = 256
DEPTH = 4
DEC_BATCH = 4
DEC_SEQ = 4096
PAST_LEN = 256

GRID_W = 64
N_MIXERS = 2
EXPAND = 2
D_INNER = EXPAND * D_MODEL
N_LRU = (DEPTH + 1) // 2
N_RWKV = DEPTH // 2
LRU_BLOCKS = 16
LRU_BLOCK = D_INNER // LRU_BLOCKS
CONV_W = 4
CONV_LEFT = 2
LRU_C = 8.0
RWKV_HEAD = 64
RWKV_HEADS = D_INNER // RWKV_HEAD
LORA_DECAY = 128
LORA_A = 128
LORA_V = 96
NORM_EPS = 1e-6
GN_EPS = 64e-5

kernel_name = 'hybrid_rglru_rwkv7_diffusion_step'


def rmsnorm(x, g):
    xf = x.astype(jnp.float32)
    y = xf * lax.rsqrt(jnp.mean(xf * xf, axis=-1, keepdims=True) + NORM_EPS)
    return (y * g.astype(jnp.float32)).astype(x.dtype)


def adaln(cond, w, b):
    m = (jax.nn.silu(cond) @ w + b)[:, None, :]
    return jnp.split(m, 3, axis=-1)


def shift_sequence(x):
    half = x.shape[-1] // 2
    prev = jnp.pad(x[:, :-1, :half], ((0, 0), (1, 0), (0, 0)))
    nxt = jnp.pad(x[:, 1:, half:], ((0, 0), (0, 1), (0, 0)))
    return jnp.concatenate([prev, nxt], axis=-1)


def shift_grid(x):
    bsz, t, d = x.shape
    rows = t // GRID_W
    q = d // 4
    g = x.reshape(bsz, rows, GRID_W, d)
    left = jnp.pad(g[:, :, :-1, :q], ((0, 0), (0, 0), (1, 0), (0, 0)))
    right = jnp.pad(g[:, :, 1:, q:2 * q], ((0, 0), (0, 0), (0, 1), (0, 0)))
    up = jnp.pad(g[:, :-1, :, 2 * q:3 * q], ((0, 0), (1, 0), (0, 0), (0, 0)))
    down = jnp.pad(g[:, 1:, :, 3 * q:], ((0, 0), (0, 1), (0, 0), (0, 0)))
    return jnp.concatenate([left, right, up, down], axis=-1).reshape(bsz, t, d)


def conv_centred(x, w, b):
    t = x.shape[1]
    xp = jnp.pad(x, ((0, 0), (CONV_LEFT, CONV_W - 1 - CONV_LEFT), (0, 0)))
    y = b
    for tap in range(CONV_W):
        y = y + xp[:, tap:tap + t] * w[tap]
    return y


def lru_scan(a, u, h0, reverse):
    def step(h, inp):
        at, ut = inp
        h = at * h + ut
        return h, h
    h_final, hs = lax.scan(step, h0, (jnp.swapaxes(a, 0, 1), jnp.swapaxes(u, 0, 1)), reverse=reverse)
    return jnp.swapaxes(hs, 0, 1), h_final


def lru_mixer(h, h0, P, j):
    bsz, t, _ = h.shape
    x, z = jnp.split(h @ P['lru_w_in'][j], 2, axis=-1)
    x = conv_centred(x, P['lru_conv_w'][j], P['lru_conv_b'][j])
    xb = x.reshape(bsz, t, LRU_BLOCKS, LRU_BLOCK)
    xf = x.astype(jnp.float32)
    ys, finals = [], []
    for d in range(2):
        gw, gb = P['lru_gate_w'][j, d], P['lru_gate_b'][j, d]
        r = jax.nn.sigmoid(jnp.einsum('btnc,nce->btne', xb, gw[0]).reshape(bsz, t, D_INNER) + gb[0])
        i = jax.nn.sigmoid(jnp.einsum('btnc,nce->btne', xb, gw[1]).reshape(bsz, t, D_INNER) + gb[1])
        log_a = -LRU_C * r.astype(jnp.float32) * jax.nn.softplus(-P['lru_lambda'][j, d].astype(jnp.float32))
        u = jnp.sqrt(-jnp.expm1(2.0 * log_a)) * (i.astype(jnp.float32) * xf)
        y_d, h_d = lru_scan(jnp.exp(log_a), u, h0[d].astype(jnp.float32), reverse=(d == 1))
        ys.append(y_d)
        finals.append(h_d)
    y = (ys[0] + ys[1]).astype(h.dtype)
    out = (y * jax.nn.silu(z)) @ P['lru_w_out'][j]
    return out, jnp.stack(finals, 0)


def to_heads(t):
    return t.reshape(t.shape[:-1] + (RWKV_HEADS, RWKV_HEAD)).astype(jnp.float32)


def rwkv_scan(r, w, k, v, a, b, s0, reverse):
    def step(s, inp):
        rt, wt, kt, vt, at, bt = inp
        sa = jnp.einsum('bhvk,bhk->bhv', s, at)
        s = s * wt[:, :, None, :] + sa[..., None] * bt[:, :, None, :] + vt[..., None] * kt[:, :, None, :]
        return s, jnp.einsum('bhvk,bhk->bhv', s, rt)
    xs = tuple(jnp.swapaxes(q, 0, 1) for q in (r, w, k, v, a, b))
    s_final, ys = lax.scan(step, s0, xs, reverse=reverse)
    return jnp.swapaxes(ys, 0, 1), s_final


def rwkv_mixer(h, s0, shift_fn, v_first, P, j):
    bsz, t, _ = h.shape
    mu = P['rwkv_mu'][j]
    xx = shift_fn(h) - h
    xr, xw, xk, xv, xa = [h + xx * mu[m] for m in range(5)]
    r = xr @ P['rwkv_w_r'][j]
    k = xk @ P['rwkv_w_k'][j]
    v = xv @ P['rwkv_w_v'][j]
    z = h @ P['rwkv_w_g'][j]
    if j > 0:
        v_mix = jax.nn.sigmoid(P['rwkv_v0'][j - 1] + (xv @ P['rwkv_v1'][j - 1]) @ P['rwkv_v2'][j - 1])
        v = v + (v_first - v) * v_mix
    rh, kh, vh = to_heads(r), to_heads(k), to_heads(v)
    kk = kh * to_heads(P['rwkv_k_k'][j])
    kk = kk / jnp.maximum(jnp.sqrt(jnp.sum(kk * kk, axis=-1, keepdims=True)), 1e-12)
    k_a = to_heads(P['rwkv_k_a'][j])
    r_k = to_heads(P['rwkv_r_k'][j])
    ys, bonus, finals = [], [], []
    for d in range(2):
        w_pre = to_heads(P['rwkv_w0'][j, d] + jnp.tanh(xw @ P['rwkv_w1'][j, d]) @ P['rwkv_w2'][j, d])
        w_log = -jax.nn.softplus(-w_pre) - 0.5
        decay = jnp.exp(-jnp.exp(w_log))
        a = jax.nn.sigmoid(to_heads(P['rwkv_a0'][j, d] + (xa @ P['rwkv_a1'][j, d]) @ P['rwkv_a2'][j, d]))
        kd = kh * (1.0 + (a - 1.0) * k_a)
        y_d, s_d = rwkv_scan(rh, decay, kd, vh, -kk, kk * a, s0[d].astype(jnp.float32), reverse=(d == 1))
        ys.append(y_d)
        bonus.append(jnp.sum(rh * kd * r_k, axis=-1, keepdims=True) * vh)
        finals.append(s_d)
    y = ys[0] + ys[1]
    mean = jnp.mean(y, axis=-1, keepdims=True)
    var = jnp.mean(jnp.square(y - mean), axis=-1, keepdims=True)
    y = (y - mean) * lax.rsqrt(var + GN_EPS) * to_heads(P['rwkv_ln_w'][j]) + to_heads(P['rwkv_ln_b'][j])
    y = (y + bonus[0] + bonus[1]).reshape(bsz, t, D_INNER).astype(h.dtype)
    out = (y * jax.nn.silu(z)) @ P['rwkv_w_o'][j]
    return out, jnp.stack(finals, 0), v


def trunk(x, cond, init_lru, init_rwkv, shift_fn, P):
    fin_lru, fin_rwkv = [], []
    v_first = None
    for i in range(DEPTH):
        shift, scale, gate = adaln(cond, P['ada_w'][i], P['ada_b'][i])
        h = rmsnorm(x, P['norm_pre'][i]) * (1 + scale) + shift
        j = i // N_MIXERS
        if i % N_MIXERS == 0:
            m, fin = lru_mixer(h, init_lru[j], P, j)
            fin_lru.append(fin)
        else:
            m, fin, v = rwkv_mixer(h, init_rwkv[j], shift_fn, v_first, P, j)
            if j == 0:
                v_first = v
            fin_rwkv.append(fin)
        x = x + gate * rmsnorm(m, P['norm_post'][i])
    return x, jnp.stack(fin_lru, 0), jnp.stack(fin_rwkv, 0)


def setup_inputs(seed: int = 0) -> dict:
    key = jax.random.key(seed)
    keys = jax.random.split(key, 48)
    ks = iter([keys[n] for n in range(48)])
    f32 = jnp.float32
    E, H, N, D = D_INNER, RWKV_HEADS, RWKV_HEAD, D_MODEL

    def nrm(shape, s):
        return jax.random.normal(next(ks), shape, f32) * s

    def uni(shape, lo, hi):
        return jax.random.uniform(next(ks), shape, f32, lo, hi)

    inp = {}
    inp['x_prompt'] = nrm((BATCH, SEQ, D), 1.0)
    inp['x_sample'] = nrm((DEC_BATCH, DEC_SEQ, D), 1.0)
    inp['state_lru'] = nrm((DEC_BATCH, N_LRU, 2, E), 0.5)
    inp['state_rwkv'] = nrm((DEC_BATCH, N_RWKV, 2, H, N, N), 0.3)
    inp['c'] = nrm((DEC_BATCH, D), 1.0)
    inp['c_ctx'] = nrm((D,), 1.0)
    inp['ada_w'] = nrm((DEPTH, D, 3 * D), D ** -0.5)
    inp['ada_b'] = nrm((DEPTH, 3 * D), 0.02)
    inp['norm_pre'] = 1.0 + nrm((DEPTH, D), 0.05)
    inp['norm_post'] = 1.0 + nrm((DEPTH, D), 0.05)
    inp['lru_w_in'] = nrm((N_LRU, D, 2 * E), D ** -0.5)
    inp['lru_conv_w'] = nrm((N_LRU, CONV_W, E), CONV_W ** -0.5)
    inp['lru_conv_b'] = nrm((N_LRU, E), 0.02)
    inp['lru_gate_w'] = nrm((N_LRU, 2, 2, LRU_BLOCKS, LRU_BLOCK, LRU_BLOCK), LRU_BLOCK ** -0.5)
    inp['lru_gate_b'] = nrm((N_LRU, 2, 2, E), 0.02)
    a_c = uni((N_LRU, 2, E), 0.9, 0.999)
    a_base = a_c ** (1.0 / LRU_C)
    inp['lru_lambda'] = jnp.log(a_base) - jnp.log1p(-a_base)
    inp['lru_w_out'] = nrm((N_LRU, E, D), E ** -0.5)
    inp['rwkv_mu'] = uni((N_RWKV, 5, D), 0.0, 1.0)
    inp['rwkv_w_r'] = nrm((N_RWKV, D, E), D ** -0.5)
    inp['rwkv_w_k'] = nrm((N_RWKV, D, E), D ** -0.5)
    inp['rwkv_w_v'] = nrm((N_RWKV, D, E), D ** -0.5)
    inp['rwkv_w_g'] = nrm((N_RWKV, D, E), D ** -0.5)
    inp['rwkv_w_o'] = nrm((N_RWKV, E, D), E ** -0.5)
    inp['rwkv_w0'] = uni((N_RWKV, 2, E), -5.0, 1.0)
    inp['rwkv_w1'] = nrm((N_RWKV, 2, D, LORA_DECAY), D ** -0.5)
    inp['rwkv_w2'] = nrm((N_RWKV, 2, LORA_DECAY, E), 0.5 * LORA_DECAY ** -0.5)
    inp['rwkv_a0'] = nrm((N_RWKV, 2, E), 0.1)
    inp['rwkv_a1'] = nrm((N_RWKV, 2, D, LORA_A), D ** -0.5)
    inp['rwkv_a2'] = nrm((N_RWKV, 2, LORA_A, E), 0.5 * LORA_A ** -0.5)
    inp['rwkv_k_k'] = 0.85 + nrm((N_RWKV, E), 0.05)
    inp['rwkv_k_a'] = 1.0 + nrm((N_RWKV, E), 0.05)
    inp['rwkv_r_k'] = nrm((N_RWKV, E), 0.1)
    inp['rwkv_ln_w'] = 1.0 + nrm((N_RWKV, E), 0.05)
    inp['rwkv_ln_b'] = nrm((N_RWKV, E), 0.02)
    inp['rwkv_v0'] = nrm((N_RWKV - 1, E), 0.1)
    inp['rwkv_v1'] = nrm((N_RWKV - 1, D, LORA_V), D ** -0.5)
    inp['rwkv_v2'] = nrm((N_RWKV - 1, LORA_V, E), 0.5 * LORA_V ** -0.5)
    return inp


def reference(x_prompt, x_sample, state_lru, state_rwkv, c, c_ctx,
              ada_w, ada_b, norm_pre, norm_post,
              lru_w_in, lru_conv_w, lru_conv_b, lru_gate_w, lru_gate_b, lru_lambda, lru_w_out,
              rwkv_mu, rwkv_w_r, rwkv_w_k, rwkv_w_v, rwkv_w_g, rwkv_w_o,
              rwkv_w0, rwkv_w1, rwkv_w2, rwkv_a0, rwkv_a1, rwkv_a2,
              rwkv_k_k, rwkv_k_a, rwkv_r_k, rwkv_ln_w, rwkv_ln_b,
              rwkv_v0, rwkv_v1, rwkv_v2):
    P = dict(ada_w=ada_w, ada_b=ada_b, norm_pre=norm_pre, norm_post=norm_post,
             lru_w_in=lru_w_in, lru_conv_w=lru_conv_w, lru_conv_b=lru_conv_b,
             lru_gate_w=lru_gate_w, lru_gate_b=lru_gate_b, lru_lambda=lru_lambda, lru_w_out=lru_w_out,
             rwkv_mu=rwkv_mu, rwkv_w_r=rwkv_w_r, rwkv_w_k=rwkv_w_k, rwkv_w_v=rwkv_w_v,
             rwkv_w_g=rwkv_w_g, rwkv_w_o=rwkv_w_o, rwkv_w0=rwkv_w0, rwkv_w1=rwkv_w1, rwkv_w2=rwkv_w2,
             rwkv_a0=rwkv_a0, rwkv_a1=rwkv_a1, rwkv_a2=rwkv_a2, rwkv_k_k=rwkv_k_k, rwkv_k_a=rwkv_k_a,
             rwkv_r_k=rwkv_r_k, rwkv_ln_w=rwkv_ln_w, rwkv_ln_b=rwkv_ln_b,
             rwkv_v0=rwkv_v0, rwkv_v1=rwkv_v1, rwkv_v2=rwkv_v2)
    bp = x_prompt.shape[0]
    zero_lru = jnp.zeros((N_LRU, 2, bp, D_INNER), jnp.float32)
    zero_rwkv = jnp.zeros((N_RWKV, 2, bp, RWKV_HEADS, RWKV_HEAD, RWKV_HEAD), jnp.float32)
    y_prompt, fin_lru, fin_rwkv = trunk(x_prompt, c_ctx[None, :], zero_lru, zero_rwkv, shift_sequence, P)
    new_state_lru = jnp.moveaxis(fin_lru, 2, 0)
    new_state_rwkv = jnp.moveaxis(fin_rwkv, 2, 0)
    init_lru = jnp.moveaxis(state_lru, 0, 2)
    init_rwkv = jnp.moveaxis(state_rwkv, 0, 2)
    y_sample, _, _ = trunk(x_sample, c, init_lru, init_rwkv, shift_grid, P)
    return (y_prompt, y_sample, new_state_lru, new_state_rwkv)
```

```cpp
#include <hip/hip_runtime.h>
#include <hip/hip_cooperative_groups.h>
#include <stdint.h>
#include <stdio.h>
namespace cg = cooperative_groups;

#define DEV __device__ __forceinline__

typedef unsigned short bf16_t;
using bf16x8 = __attribute__((ext_vector_type(8))) short;
using f32x4 = __attribute__((ext_vector_type(4))) float;

static constexpr int DM = 2048;
static constexpr int EI = 4096;
static constexpr int TCTX = 8192;
static constexpr int TTOK = 24576;
static constexpr size_t OFF_LRU = 50331648ull;
static constexpr size_t OFF_RWKV = 50855936ull;

struct Params {
  const float *x_prompt, *x_sample, *state_lru, *state_rwkv, *c, *c_ctx, *ada_w, *ada_b, *norm_pre, *norm_post;
  const float *lru_w_in, *lru_conv_w, *lru_conv_b, *lru_gate_w, *lru_gate_b, *lru_lambda, *lru_w_out;
  const float *mu, *w_r, *w_k, *w_v, *w_g, *w_o, *w0, *w1, *w2, *a0, *a1, *a2, *k_k, *k_a, *r_k, *ln_w, *ln_b, *v0, *v1, *v2;
  float* out;
  float* MOD;
  bf16_t* WB;
  bf16_t* W2T;
  bf16_t* A2T;
  bf16_t* H;
  bf16_t* BA;
  bf16_t* BB;
  bf16_t* BC;
  bf16_t* VF;
  bf16_t* LORA1;
  float* BS;
  unsigned* BAR;
};

DEV bf16_t f2bf(float f) {
  uint32_t u = __float_as_uint(f);
  u += 0x7fffu + ((u >> 16) & 1u);
  return (bf16_t)(u >> 16);
}
DEV float bf2f(bf16_t h) { return __uint_as_float(((uint32_t)h) << 16); }
DEV float bfs(short h) { return __uint_as_float(((uint32_t)(unsigned short)h) << 16); }
DEV float rcpf_(float x) { return __builtin_amdgcn_rcpf(x); }
DEV float sigmoidf_(float x) { return rcpf_(1.f + __expf(-x)); }
DEV float siluf_(float x) { return x * rcpf_(1.f + __expf(-x)); }
DEV float wave_sum(float v) {
#pragma unroll
  for (int o = 32; o > 0; o >>= 1) v += __shfl_xor(v, o, 64);
  return v;
}
typedef __bf16 bf2_t __attribute__((ext_vector_type(2)));
typedef float fl2_t __attribute__((ext_vector_type(2)));
DEV uint32_t pack2bf(float a, float b) {
  fl2_t v = {a, b};
  bf2_t r = __builtin_convertvector(v, bf2_t);
  return *(uint32_t*)&r;
}
DEV bf16x8 pack8bf(float a0, float a1, float a2, float a3, float a4, float a5, float a6, float a7) {
  union { uint32_t u[4]; bf16x8 v; } x;
  x.u[0] = pack2bf(a0, a1); x.u[1] = pack2bf(a2, a3); x.u[2] = pack2bf(a4, a5); x.u[3] = pack2bf(a6, a7);
  return x.v;
}
DEV int opq(int v) { asm volatile("" : "+v"(v)); return v; }
DEV int opqs(int v) { asm volatile("" : "+s"(v)); return v; }
DEV int lane_id_() { return (int)__builtin_amdgcn_mbcnt_hi(~0u, __builtin_amdgcn_mbcnt_lo(~0u, 0u)); }
#define TID opq(wv * 64 + lane_id_())
#define BID opqs((int)blockIdx.x)
template <int CTRL>
DEV float dpp_f(float x) {
  int xi = __builtin_bit_cast(int, x);
  return __builtin_bit_cast(float, __builtin_amdgcn_update_dpp(xi, xi, CTRL, 0xf, 0xf, true));
}
DEV float row_sum16(float x) {
  x += dpp_f<0xB1>(x);
  x += dpp_f<0x4E>(x);
  x += dpp_f<0x124>(x);
  x += dpp_f<0x128>(x);
  return x;
}
DEV float rdlane(float x, int l) { return __builtin_bit_cast(float, __builtin_amdgcn_readlane(__builtin_bit_cast(int, x), l)); }
DEV float wave_sum_fast(float x) {
  x = row_sum16(x);
  return (rdlane(x, 0) + rdlane(x, 16)) + (rdlane(x, 32) + rdlane(x, 48));
}
DEV void store4bf(bf16_t* p, f32x4 v) {
  uint2 u;
  u.x = pack2bf(v[0], v[1]);
  u.y = pack2bf(v[2], v[3]);
  *(uint2*)p = u;
}
DEV f32x4 load4bf(const bf16_t* p) {
  uint2 u = *(const uint2*)p;
  f32x4 v;
  v[0] = __uint_as_float(u.x << 16);
  v[1] = __uint_as_float(u.x & 0xffff0000u);
  v[2] = __uint_as_float(u.y << 16);
  v[3] = __uint_as_float(u.y & 0xffff0000u);
  return v;
}

DEV void transpose_tile(const float* __restrict__ in, int ldin, bf16_t* __restrict__ out, int ldout, int r0, int c0, char* smem, int tid) {
  float (*t)[65] = (float (*)[65])smem;
  float4 v[4];
#pragma unroll
  for (int i = 0; i < 4; ++i) {
    int idx = tid + 256 * i;
    int r = idx >> 4, c4 = (idx & 15) * 4;
    v[i] = *(const float4*)(in + (size_t)(r0 + r) * ldin + c0 + c4);
  }
#pragma unroll
  for (int i = 0; i < 4; ++i) {
    int idx = tid + 256 * i;
    int r = idx >> 4, c4 = (idx & 15) * 4;
    t[r][c4] = v[i].x; t[r][c4 + 1] = v[i].y; t[r][c4 + 2] = v[i].z; t[r][c4 + 3] = v[i].w;
  }
  __syncthreads();
  uint32_t o[8];
#pragma unroll
  for (int i = 0; i < 8; ++i) {
    int idx = tid + 256 * i;
    int cc = idx >> 5, rp = idx & 31;
    o[i] = pack2bf(t[2 * rp][cc], t[2 * rp + 1][cc]);
  }
#pragma unroll
  for (int i = 0; i < 8; ++i) {
    int idx = tid + 256 * i;
    int cc = idx >> 5, rp = idx & 31;
    *(uint32_t*)(out + (size_t)(c0 + cc) * ldout + r0 + 2 * rp) = o[i];
  }
  __syncthreads();
}

DEV void transpose_tiles4(const float* const (&in)[4], const size_t (&rc)[4], int ldin, bf16_t* const (&out)[4], const size_t (&oc)[4], int ldout,
                          int nvalid, char* smem, int tid) {
  float (*t)[64][65] = (float (*)[64][65])smem;
  float4 v[4][4];
#pragma unroll
  for (int q = 0; q < 4; ++q)
    if (q < nvalid) {
#pragma unroll
      for (int i = 0; i < 4; ++i) {
        int idx = tid + 256 * i;
        int r = idx >> 4, c4 = (idx & 15) * 4;
        v[q][i] = *(const float4*)(in[q] + rc[q] + (size_t)r * ldin + c4);
      }
    }
#pragma unroll
  for (int q = 0; q < 4; ++q)
    if (q < nvalid) {
#pragma unroll
      for (int i = 0; i < 4; ++i) {
        int idx = tid + 256 * i;
        int r = idx >> 4, c4 = (idx & 15) * 4;
        t[q][r][c4] = v[q][i].x; t[q][r][c4 + 1] = v[q][i].y; t[q][r][c4 + 2] = v[q][i].z; t[q][r][c4 + 3] = v[q][i].w;
      }
    }
  __syncthreads();
#pragma unroll
  for (int q = 0; q < 4; ++q)
    if (q < nvalid) {
#pragma unroll
      for (int i = 0; i < 8; ++i) {
        int idx = tid + 256 * i;
        int cc = idx >> 5, rp = idx & 31;
        *(uint32_t*)(out[q] + oc[q] + (size_t)cc * ldout + 2 * rp) = pack2bf(t[q][2 * rp][cc], t[q][2 * rp + 1][cc]);
      }
    }
  __syncthreads();
}

DEV void convert_wt(const float* W, int K, int N, bf16_t* WT, int worker, int nworkers, char* smem, int tid);
DEV void phase_prep(const int wv, const Params& p, char* smem) {
  float* sc = (float*)smem;
  float* red = sc + 5 * 2048;
  const int tid = TID, bid = BID;
  for (int i = tid; i < 5 * 2048; i += 256) {
    int c = i >> 11, k = i & 2047;
    float v = (c == 0) ? p.c_ctx[k] : p.c[(c - 1) * 2048 + k];
    sc[i] = siluf_(v);
  }
  __syncthreads();
  int cq = tid & 7, kl = tid >> 3;
  for (int item = bid; item < 768; item += gridDim.x) {
    int l = item / 192, cgp = item % 192;
    int c0 = cgp * 32;
    const float* W = p.ada_w + (size_t)l * 2048 * 6144 + c0 + cq * 4;
    float acc[5][4];
#pragma unroll
    for (int c = 0; c < 5; ++c)
#pragma unroll
      for (int q = 0; q < 4; ++q) acc[c][q] = 0.f;
#pragma unroll 4
    for (int k = kl; k < 2048; k += 32) {
      float4 w4 = *(const float4*)(W + (size_t)k * 6144);
#pragma unroll
      for (int c = 0; c < 5; ++c) {
        float s = sc[c * 2048 + k];
        acc[c][0] += s * w4.x; acc[c][1] += s * w4.y; acc[c][2] += s * w4.z; acc[c][3] += s * w4.w;
      }
    }
    float* r = red + (kl * 8 + cq) * 20;
#pragma unroll
    for (int c = 0; c < 5; ++c)
#pragma unroll
      for (int q = 0; q < 4; ++q) r[c * 4 + q] = acc[c][q];
    __syncthreads();
    if (tid < 160) {
      int c = tid >> 5, col = tid & 31;
      float s = 0.f;
      for (int kk = 0; kk < 32; ++kk) s += red[(kk * 8 + (col >> 2)) * 20 + c * 4 + (col & 3)];
      p.MOD[(size_t)(l * 5 + c) * 6144 + c0 + col] = s + p.ada_b[l * 6144 + c0 + col];
    }
    __syncthreads();
  }
  for (int item = bid; item < 1024; item += gridDim.x) {
    int which = item >> 9;
    int rem = item & 511;
    int mat = rem >> 7, tl = rem & 127;
    const float* src = (which == 0 ? p.w2 : p.a2) + (size_t)mat * 128 * 4096;
    bf16_t* dst = (which == 0 ? p.W2T : p.A2T) + (size_t)mat * 4096 * 128;
    transpose_tile(src, 4096, dst, 128, (tl & 1) * 64, (tl >> 1) * 64, smem, tid);
  }
}

DEV void phase_row(const int wv, const Params& p, int layer, char* smem) {
  const int tid = TID, bid = BID;
  int lane = tid & 63, w = tid >> 6;
  for (int g = bid * 4 + w; g < TTOK; g += gridDim.x * 4) {
    int c = g < TCTX ? 0 : 1 + ((g - TCTX) >> 12);
    const float* xin;
    if (layer <= 1) xin = g < TCTX ? p.x_prompt + (size_t)g * DM : p.x_sample + (size_t)(g - TCTX) * DM;
    else xin = p.out + (size_t)g * DM;
    float4 x[8];
#pragma unroll
    for (int q = 0; q < 8; ++q) x[q] = ((const float4*)xin)[q * 64 + lane];
    if (layer > 0) {
      const float* M = (const float*)(((layer - 1) & 1) == 0 ? p.BC : p.BB) + (size_t)g * DM;
      float4 m[8];
      float ss = 0.f;
#pragma unroll
      for (int q = 0; q < 8; ++q) {
        m[q] = ((const float4*)M)[q * 64 + lane];
        ss += m[q].x * m[q].x + m[q].y * m[q].y + m[q].z * m[q].z + m[q].w * m[q].w;
      }
      ss = wave_sum_fast(ss);
      float rs = __builtin_amdgcn_rsqf(ss * (1.f / 2048.f) + 1e-6f);
      const float4* gate = (const float4*)(p.MOD + (size_t)((layer - 1) * 5 + c) * 6144 + 4096);
      const float4* np = (const float4*)(p.norm_post + (layer - 1) * DM);
#pragma unroll
      for (int q = 0; q < 8; ++q) {
        float4 gt = gate[q * 64 + lane], nn = np[q * 64 + lane];
        x[q].x += gt.x * (m[q].x * rs * nn.x);
        x[q].y += gt.y * (m[q].y * rs * nn.y);
        x[q].z += gt.z * (m[q].z * rs * nn.z);
        x[q].w += gt.w * (m[q].w * rs * nn.w);
        ((float4*)(p.out + (size_t)g * DM))[q * 64 + lane] = x[q];
      }
    }
    if (layer < 4) {
      float ss = 0.f;
#pragma unroll
      for (int q = 0; q < 8; ++q) ss += x[q].x * x[q].x + x[q].y * x[q].y + x[q].z * x[q].z + x[q].w * x[q].w;
      ss = wave_sum_fast(ss);
      float rs = __builtin_amdgcn_rsqf(ss * (1.f / 2048.f) + 1e-6f);
      const float4* sh = (const float4*)(p.MOD + (size_t)(layer * 5 + c) * 6144);
      const float4* scl = (const float4*)(p.MOD + (size_t)(layer * 5 + c) * 6144 + 2048);
      const float4* np = (const float4*)(p.norm_pre + layer * DM);
#pragma unroll
      for (int q = 0; q < 8; ++q) {
        float4 s1 = sh[q * 64 + lane], s2 = scl[q * 64 + lane], nn = np[q * 64 + lane];
        f32x4 h;
        h[0] = x[q].x * rs * nn.x * (1.f + s2.x) + s1.x;
        h[1] = x[q].y * rs * nn.y * (1.f + s2.y) + s1.y;
        h[2] = x[q].z * rs * nn.z * (1.f + s2.z) + s1.z;
        h[3] = x[q].w * rs * nn.w * (1.f + s2.w) + s1.w;
        store4bf(p.H + (size_t)g * DM + (q * 64 + lane) * 4, h);
      }
    }
  }
  if (layer < 4) {
    const int j = layer >> 1;
    const int G = gridDim.x;
    if ((layer & 1) == 0) {
      for (int it0 = bid; it0 < 1024; it0 += 4 * G) {
        const float* in[4]; bf16_t* out[4]; size_t rc[4], oc[4];
        int nvalid = 0;
#pragma unroll
        for (int q = 0; q < 4; ++q) {
          const int item = it0 + q * G;
          const int ic = item < 1024 ? item : it0;
          const int mat = ic >> 4, tl = ic & 15;
          in[q] = p.lru_gate_w + (size_t)(j * 64 + mat) * 65536;
          out[q] = p.WB + (size_t)mat * 65536;
          rc[q] = (size_t)((tl >> 2) * 64) * 256 + (tl & 3) * 64;
          oc[q] = (size_t)((tl & 3) * 64) * 256 + (tl >> 2) * 64;
          nvalid += (item < 1024) ? 1 : 0;
        }
        transpose_tiles4(in, rc, 256, out, oc, 256, nvalid, smem, tid);
      }
      convert_wt(p.lru_w_in + (size_t)j * DM * 8192, DM, 8192, p.WB + ((size_t)DM * EI), bid, G, smem, tid);
    } else {
      convert_wt(p.w_v + (size_t)j * DM * EI, DM, EI, p.WB, bid, G, smem, tid);
      convert_wt(p.w_r + (size_t)j * DM * EI, DM, EI, p.WB + ((size_t)DM * EI), bid, G, smem, tid);
      convert_wt(p.w_k + (size_t)j * DM * EI, DM, EI, p.WB + 2 * ((size_t)DM * EI), bid, G, smem, tid);
    }
  }
}

struct ALPlain {
  const bf16_t* p;
  int ld;
  struct Raw { bf16x8 v; };
  DEV void prep(int k) {}
  DEV void fetch(int row, int k, Raw& r) const { r.v = *(const bf16x8*)(p + (size_t)row * ld + k); }
  DEV bf16x8 finish(const Raw& r) const { return r.v; }
};
struct EpBF16 {
  bf16_t* C; int ldc;
  DEV void operator()(int m, int n, f32x4 v) const { store4bf(C + (size_t)m * ldc + n, v); }
};
struct EpXZ {
  bf16_t* X; bf16_t* Z;
  DEV void operator()(int m, int n, f32x4 v) const {
    if (n < EI) store4bf(X + (size_t)m * EI + n, v);
    else {
      f32x4 s;
#pragma unroll
      for (int i = 0; i < 4; ++i) s[i] = siluf_(v[i]);
      store4bf(Z + (size_t)m * EI + (n - EI), s);
    }
  }
};
struct EpF32 {
  float* C; int ldc;
  DEV void operator()(int m, int n, f32x4 v) const { *(f32x4*)(C + (size_t)m * ldc + n) = v; }
};
struct EpLora {
  bf16_t* C; int do_tanh;
  DEV void operator()(int m, int n, f32x4 v) const {
    if (do_tanh) {
#pragma unroll
      for (int i = 0; i < 4; ++i) { float xc = fminf(fmaxf(v[i], -15.f), 15.f); v[i] = 1.f - 2.f * rcpf_(1.f + __expf(2.f * xc)); }
    }
    store4bf(C + (size_t)m * 640 + n, v);
  }
};
struct EpVmix {
  bf16_t* C; const float* v0;
  DEV void operator()(int m, int n, f32x4 v) const {
    f32x4 b = *(const f32x4*)(v0 + n);
#pragma unroll
    for (int i = 0; i < 4; ++i) v[i] = sigmoidf_(v[i] + b[i]);
    store4bf(C + (size_t)m * EI + n, v);
  }
};
struct EpVmixV {
  bf16_t* VFp; const bf16_t* MIX;
  DEV void operator()(int m, int n, f32x4 v) const {
    f32x4 vf = load4bf(VFp + (size_t)m * EI + n);
    f32x4 mx = load4bf(MIX + (size_t)m * EI + n);
#pragma unroll
    for (int i = 0; i < 4; ++i) v[i] = v[i] + (vf[i] - v[i]) * mx[i];
    store4bf(VFp + (size_t)m * EI + n, v);
  }
};
struct EpZ {
  bf16_t* Y;
  DEV void operator()(int m, int n, f32x4 v) const {
    f32x4 y = load4bf(Y + (size_t)m * EI + n);
#pragma unroll
    for (int i = 0; i < 4; ++i) y[i] = y[i] * siluf_(v[i]);
    store4bf(Y + (size_t)m * EI + n, y);
  }
};

template <bool CHK, class AL, class EP>
DEV void gemm_tile(AL al, const float* __restrict__ Bp, int ldb, int Kv, int Nv, int K, int m0, int n0, const EP& ep, char* smem, const int tid) {
  bf16_t (*As)[80] = (bf16_t (*)[80])smem;
  bf16_t (*Bs)[80] = (bf16_t (*)[80])(smem + 128 * 80 * 2);
  const int lane = tid & 63, w = tid >> 6, wm = w >> 1, wn = w & 1;
  f32x4 acc[4][4];
#pragma unroll
  for (int i = 0; i < 4; ++i)
#pragma unroll
    for (int j = 0; j < 4; ++j) acc[i][j] = f32x4{0.f, 0.f, 0.f, 0.f};
  typename AL::Raw ra[4];
  float4 rb[8];
  const int arow = tid >> 3, akc = (tid & 7) * 8;
  const int bkg = tid >> 5, bnq = tid & 31;
  const int nk = K >> 6;
  const int bn = n0 + bnq * 4;

  const bool nok = bn < Nv;
  const int bnc = nok ? bn : 0;
  auto fetch = [&](int kt) {
#pragma unroll
    for (int i = 0; i < 4; ++i) al.fetch(m0 + arow + 32 * i, kt * 64 + akc, ra[i]);
    const int k0 = kt * 64 + bkg * 8;
    const bool ok = CHK ? (nok && (k0 < Kv)) : true;
    const float* bp = Bp + (size_t)(ok ? k0 : 0) * ldb + bnc;
#pragma unroll
    for (int i = 0; i < 8; ++i) {
      float4 v = *(const float4*)bp;
      bp += ldb;
      rb[i] = ok ? v : float4{0.f, 0.f, 0.f, 0.f};
    }
  };
  fetch(0);
  for (int kt = 0; kt < nk; ++kt) {
    al.prep(kt * 64 + akc);
#pragma unroll
    for (int i = 0; i < 4; ++i) *(bf16x8*)&As[arow + 32 * i][akc] = al.finish(ra[i]);
    {
      bf16x8 v0 = pack8bf(rb[0].x, rb[1].x, rb[2].x, rb[3].x, rb[4].x, rb[5].x, rb[6].x, rb[7].x);
      bf16x8 v1 = pack8bf(rb[0].y, rb[1].y, rb[2].y, rb[3].y, rb[4].y, rb[5].y, rb[6].y, rb[7].y);
      bf16x8 v2 = pack8bf(rb[0].z, rb[1].z, rb[2].z, rb[3].z, rb[4].z, rb[5].z, rb[6].z, rb[7].z);
      bf16x8 v3 = pack8bf(rb[0].w, rb[1].w, rb[2].w, rb[3].w, rb[4].w, rb[5].w, rb[6].w, rb[7].w);
      *(bf16x8*)&Bs[bnq * 4 + 0][bkg * 8] = v0;
      *(bf16x8*)&Bs[bnq * 4 + 1][bkg * 8] = v1;
      *(bf16x8*)&Bs[bnq * 4 + 2][bkg * 8] = v2;
      *(bf16x8*)&Bs[bnq * 4 + 3][bkg * 8] = v3;
    }
    __syncthreads();
    if (kt + 1 < nk) fetch(kt + 1);
#pragma unroll
    for (int ks = 0; ks < 2; ++ks) {
      bf16x8 af[4], bfr[4];
#pragma unroll
      for (int i = 0; i < 4; ++i) af[i] = *(const bf16x8*)&As[wm * 64 + i * 16 + (lane & 15)][ks * 32 + (lane >> 4) * 8];
#pragma unroll
      for (int j = 0; j < 4; ++j) bfr[j] = *(const bf16x8*)&Bs[wn * 64 + j * 16 + (lane & 15)][ks * 32 + (lane >> 4) * 8];
#pragma unroll
      for (int i = 0; i < 4; ++i)
#pragma unroll
        for (int j = 0; j < 4; ++j) acc[i][j] = __builtin_amdgcn_mfma_f32_16x16x32_bf16(bfr[j], af[i], acc[i][j], 0, 0, 0);
    }
    __syncthreads();
  }
#pragma unroll
  for (int i = 0; i < 4; ++i)
#pragma unroll
    for (int j = 0; j < 4; ++j) ep(m0 + wm * 64 + i * 16 + (lane & 15), n0 + wn * 64 + j * 16 + (lane >> 4) * 4, acc[i][j]);
}

static constexpr int GBN = 256;
template <class EP>
DEV void gemm_tile_bt(const bf16_t* __restrict__ Ap, int lda, const bf16_t* __restrict__ Bt, int K, int m0, int n0, const EP& ep, char* smem, const int tid) {
  bf16_t (*As)[48] = (bf16_t (*)[48])smem;
  bf16_t (*Bs)[48] = (bf16_t (*)[48])(smem + 128 * 48 * 2);
  const int lane = tid & 63, w = tid >> 6, wm = w >> 1, wn = w & 1;
  f32x4 acc[4][8];
#pragma unroll
  for (int i = 0; i < 4; ++i)
#pragma unroll
    for (int j = 0; j < 8; ++j) acc[i][j] = f32x4{0.f, 0.f, 0.f, 0.f};
  bf16x8 ra0[2], rb0[4];
  const int arow = tid >> 2, akc = (tid & 3) * 8;
  const int nk = K >> 5;
  const bf16_t* Ag = Ap + (size_t)(m0 + arow) * lda + akc;
  const bf16_t* Bg = Bt + (size_t)(n0 + arow) * K + akc;
#define BT_FETCH(kt, ra, rb)                                                                      \
  {                                                                                                \
    _Pragma("unroll") for (int i = 0; i < 2; ++i) ra[i] = *(const bf16x8*)(Ag + (size_t)(64 * i) * lda + (kt) * 32); \
    _Pragma("unroll") for (int i = 0; i < 4; ++i) rb[i] = *(const bf16x8*)(Bg + (size_t)(64 * i) * K + (kt) * 32);   \
  }
#define BT_STEP(kt, ra, rb)                                                                        \
  {                                                                                                \
    _Pragma("unroll") for (int i = 0; i < 2; ++i) *(bf16x8*)&As[arow + 64 * i][akc] = ra[i];      \
    _Pragma("unroll") for (int i = 0; i < 4; ++i) *(bf16x8*)&Bs[arow + 64 * i][akc] = rb[i];      \
    __syncthreads();                                                                               \
    if ((kt) + 1 < nk) BT_FETCH((kt) + 1, ra, rb)                                                  \
    {                                                                                              \
      bf16x8 af[4];                                                                                \
      _Pragma("unroll") for (int i = 0; i < 4; ++i) af[i] = *(const bf16x8*)&As[wm * 64 + i * 16 + (lane & 15)][(lane >> 4) * 8];  \
      _Pragma("unroll") for (int jh = 0; jh < 2; ++jh) {                                           \
        bf16x8 bfr[4];                                                                             \
        _Pragma("unroll") for (int j = 0; j < 4; ++j) bfr[j] = *(const bf16x8*)&Bs[wn * 128 + (jh * 4 + j) * 16 + (lane & 15)][(lane >> 4) * 8]; \
        _Pragma("unroll") for (int i = 0; i < 4; ++i)                                              \
          _Pragma("unroll") for (int j = 0; j < 4; ++j) acc[i][jh * 4 + j] = __builtin_amdgcn_mfma_f32_16x16x32_bf16(bfr[j], af[i], acc[i][jh * 4 + j], 0, 0, 0); \
        __builtin_amdgcn_sched_barrier(0);                                                         \
      }                                                                                            \
    }                                                                                              \
    __syncthreads();                                                                               \
  }
  BT_FETCH(0, ra0, rb0)
  for (int kt = 0; kt < nk; ++kt) {
    BT_STEP(kt, ra0, rb0)
  }
#undef BT_FETCH
#undef BT_STEP
#pragma unroll
  for (int i = 0; i < 4; ++i)
#pragma unroll
    for (int j = 0; j < 8; ++j) ep(m0 + wm * 64 + i * 16 + (lane & 15), n0 + wn * 128 + j * 16 + (lane >> 4) * 4, acc[i][j]);
}

DEV void convert_wt(const float* W, int K, int N, bf16_t* WT, int worker, int nworkers, char* smem, int tid) {
  const int nt_n = N >> 6;
  const int total = (K >> 6) * nt_n;
  for (int t0 = worker; t0 < total; t0 += 4 * nworkers) {
    const float* in[4] = {W, W, W, W};
    bf16_t* out[4] = {WT, WT, WT, WT};
    size_t rc[4], oc[4];
    int nvalid = 0;
#pragma unroll
    for (int q = 0; q < 4; ++q) {
      const int t = t0 + q * nworkers;
      const int tc = t < total ? t : t0;
      const int kt = tc / nt_n, nt = tc % nt_n;
      rc[q] = (size_t)(kt * 64) * N + nt * 64;
      oc[q] = (size_t)(nt * 64) * K + kt * 64;
      nvalid += (t < total) ? 1 : 0;
    }
    transpose_tiles4(in, rc, N, out, oc, K, nvalid, smem, tid);
  }
}

DEV void tile_map(int t, int lognt, int& mt, int& nt) {
  if (gridDim.x == 512) {
    const int r = t >> 9, b = t & 511;
    const int xcd = b & 7, slot = b >> 3;
    const int logpc = lognt - 3;
    const int pc = xcd & ((1 << logpc) - 1), pr = xcd >> logpc;
    mt = r * (64 >> logpc) + pr * 8 + (slot >> 3);
    nt = pc * 8 + (slot & 7);
  } else {
    nt = t & ((1 << lognt) - 1);
    mt = t >> lognt;
  }
}
static constexpr int MT = TTOK / 128;

DEV void phase_lru_in(const int wv, const Params& p, int j, char* smem) {
  const int tid = TID, bid = BID;
  EpXZ ep{p.BA, p.BB};
  const bf16_t* Bt = p.WB + ((size_t)DM * EI);
  for (int t = bid; t < MT * 32; t += gridDim.x) {
    int nt, mt; tile_map(t, 5, mt, nt);
    gemm_tile_bt(p.H, DM, Bt, DM, mt * 128, nt * GBN, ep, smem, tid);
  }
}
DEV void phase_out_proj(const int wv, const Params& p, const bf16_t* A, const bf16_t* Wt, float* Mout, char* smem) {
  const int tid = TID, bid = BID;
  EpF32 ep{Mout, DM};
  for (int t = bid; t < MT * 8; t += gridDim.x) {
    int nt, mt; tile_map(t, 3, mt, nt);
    gemm_tile_bt(A, EI, Wt, EI, mt * 128, nt * GBN, ep, smem, tid);
  }
}
DEV void phase_conv(const int wv, const Params& p, int j, char* smem) {
  const bf16_t* XB = p.BA;
  bf16_t* XC = p.BC;
  const float* cw = p.lru_conv_w + (size_t)j * 4 * EI;
  const float* cb = p.lru_conv_b + (size_t)j * EI;
  const int total = TTOK * 512;
  const int tid = TID, bid = BID;
  for (int idx = bid * 256 + tid; idx < total; idx += gridDim.x * 256) {
    int g = idx >> 9, e = (idx & 511) * 8;
    int t, L;
    if (g < TCTX) { t = g & 255; L = 256; } else { t = (g - TCTX) & 4095; L = 4096; }
    float acc[8];
    {
      float4 b0 = *(const float4*)(cb + e), b1 = *(const float4*)(cb + e + 4);
      acc[0] = b0.x; acc[1] = b0.y; acc[2] = b0.z; acc[3] = b0.w; acc[4] = b1.x; acc[5] = b1.y; acc[6] = b1.z; acc[7] = b1.w;
    }
#pragma unroll
    for (int tap = 0; tap < 4; ++tap) {
      int tt = t + tap - 2;
      if (tt >= 0 && tt < L) {
        bf16x8 xv = *(const bf16x8*)(XB + (size_t)(g + tap - 2) * EI + e);
        float4 w0 = *(const float4*)(cw + tap * EI + e), w1 = *(const float4*)(cw + tap * EI + e + 4);
        acc[0] += w0.x * bfs(xv[0]); acc[1] += w0.y * bfs(xv[1]); acc[2] += w0.z * bfs(xv[2]); acc[3] += w0.w * bfs(xv[3]);
        acc[4] += w1.x * bfs(xv[4]); acc[5] += w1.y * bfs(xv[5]); acc[6] += w1.z * bfs(xv[6]); acc[7] += w1.w * bfs(xv[7]);
      }
    }
    *(bf16x8*)(XC + (size_t)g * EI + e) = pack8bf(acc[0], acc[1], acc[2], acc[3], acc[4], acc[5], acc[6], acc[7]);
  }
  convert_wt(p.lru_w_out + (size_t)j * EI * DM, EI, DM, p.WB + ((size_t)DM * EI), bid, gridDim.x, smem, tid);
}

DEV void lru_item(const Params& p, int j, int item, char* smem, const int tid) {
  float (*sA)[64][64] = (float (*)[64][64])smem;
  float (*sU)[64][64] = (float (*)[64][64])(smem + 32768);
  const bf16_t* XC = p.BC;
  const bf16_t* ZB = p.BB;
  bf16_t* Y = p.BA;
  const int lane = tid & 63, w = tid >> 6;
  int s, n, sl;
  if (item < 256) { s = 32 + (item >> 6); n = (item & 63) >> 2; sl = item & 3; }
  else { int i2 = item - 256; s = i2 >> 6; n = (i2 & 63) >> 2; sl = i2 & 3; }
  const int L = s < 32 ? 256 : 4096;
  const size_t g0 = s < 32 ? (size_t)s * 256 : (size_t)TCTX + (size_t)(s - 32) * 4096;
  const int NT = L >> 6;
  const int e0 = n * 256 + sl * 64;
  const int sd = tid >> 6, sch = tid & 63;
  float hst = 0.f;
  if (tid < 128 && s >= 32) hst = p.state_lru[(size_t)(((s - 32) * 2 + j) * 2 + sd) * EI + e0 + sch];
  const int ch = w * 16 + (lane & 15);
  float gbr[2], gbi[2], sp[2];
#pragma unroll
  for (int d = 0; d < 2; ++d) {
    gbr[d] = p.lru_gate_b[(size_t)((j * 2 + d) * 2 + 0) * EI + e0 + ch];
    gbi[d] = p.lru_gate_b[(size_t)((j * 2 + d) * 2 + 1) * EI + e0 + ch];
    float lam = p.lru_lambda[(size_t)(j * 2 + d) * EI + e0 + ch];
    float xx = -lam;
    { float tt = __expf(xx); float ser = tt * (1.f + tt * (-0.5f + tt * (0.33333334f + tt * (-0.25f + tt * 0.2f)))); sp[d] = xx > 20.f ? xx : (tt < 0.05f ? ser : __logf(1.f + tt)); }
  }
  for (int it = 0; it < NT; ++it) {
    const bool first = it < (NT >> 1);
    bf16x8 partv[2][2], zv[2][2];
    {
      const size_t gt0 = g0 + (size_t)it * 64, gt1 = g0 + (size_t)(NT - 1 - it) * 64;
      bf16_t (*At)[64][272] = (bf16_t (*)[64][272])smem;
      bf16x8 areg[2][8];
#pragma unroll
      for (int i = 0; i < 8; ++i) {
        const int id = tid + 256 * i;
        const int row = id >> 5, c8 = (id & 31) * 8;
        areg[0][i] = *(const bf16x8*)(XC + (gt0 + row) * EI + n * 256 + c8);
        areg[1][i] = *(const bf16x8*)(XC + (gt1 + row) * EI + n * 256 + c8);
      }
      const bf16_t* Bw0r = p.WB + ((((size_t)0 * 2 + 0) * 16 + n) * 256 + (sl * 64 + ch)) * 256 + (lane >> 4) * 8;
      const bf16_t* Bw0i = p.WB + ((((size_t)0 * 2 + 1) * 16 + n) * 256 + (sl * 64 + ch)) * 256 + (lane >> 4) * 8;
      const bf16_t* Bw1r = p.WB + ((((size_t)1 * 2 + 0) * 16 + n) * 256 + (sl * 64 + ch)) * 256 + (lane >> 4) * 8;
      const bf16_t* Bw1i = p.WB + ((((size_t)1 * 2 + 1) * 16 + n) * 256 + (sl * 64 + ch)) * 256 + (lane >> 4) * 8;
      bf16x8 brA[4], biA[4], brB[4], biB[4];
#define LRU_LOADB(BR, BI, PR, PI, half) \
  _Pragma("unroll") for (int ks = 0; ks < 4; ++ks) { BR[ks] = *(const bf16x8*)(PR + ((half) * 4 + ks) * 32); BI[ks] = *(const bf16x8*)(PI + ((half) * 4 + ks) * 32); }
#define LRU_MMA(d, half, BR, BI)                                                                                  \
  _Pragma("unroll") for (int ks = 0; ks < 4; ++ks)                                                                \
    _Pragma("unroll") for (int mb = 0; mb < 4; ++mb) {                                                            \
      const bf16x8 af = *(const bf16x8*)&At[d][mb * 16 + (lane & 15)][((half) * 4 + ks) * 32 + (lane >> 4) * 8]; \
      ar[d][mb] = __builtin_amdgcn_mfma_f32_16x16x32_bf16(af, BR[ks], ar[d][mb], 0, 0, 0);                        \
      ai[d][mb] = __builtin_amdgcn_mfma_f32_16x16x32_bf16(af, BI[ks], ai[d][mb], 0, 0, 0);                        \
    }
      LRU_LOADB(brA, biA, Bw0r, Bw0i, 0)
      LRU_LOADB(brB, biB, Bw0r, Bw0i, 1)
      __builtin_amdgcn_sched_barrier(0);
#pragma unroll
      for (int i = 0; i < 8; ++i) {
        const int id = tid + 256 * i;
        const int row = id >> 5, c8 = (id & 31) * 8;
        *(bf16x8*)&At[0][row][c8] = areg[0][i];
        *(bf16x8*)&At[1][row][c8] = areg[1][i];
      }
      __syncthreads();
      f32x4 ar[2][4], ai[2][4];
#pragma unroll
      for (int d = 0; d < 2; ++d)
#pragma unroll
        for (int mb = 0; mb < 4; ++mb) { ar[d][mb] = f32x4{0.f, 0.f, 0.f, 0.f}; ai[d][mb] = f32x4{0.f, 0.f, 0.f, 0.f}; }
      LRU_MMA(0, 0, brA, biA)
      __builtin_amdgcn_sched_barrier(0);
      LRU_LOADB(brA, biA, Bw1r, Bw1i, 0)
      LRU_MMA(0, 1, brB, biB)
      __builtin_amdgcn_sched_barrier(0);
      LRU_LOADB(brB, biB, Bw1r, Bw1i, 1)
      LRU_MMA(1, 0, brA, biA)
      __builtin_amdgcn_sched_barrier(0);
      LRU_MMA(1, 1, brB, biB)
#undef LRU_LOADB
#undef LRU_MMA
      unsigned short xfr[2][4][4];
#pragma unroll
      for (int d = 0; d < 2; ++d)
#pragma unroll
        for (int mb = 0; mb < 4; ++mb)
#pragma unroll
          for (int r = 0; r < 4; ++r) xfr[d][mb][r] = At[d][mb * 16 + (lane >> 4) * 4 + r][sl * 64 + ch];
      if (!first) {
#pragma unroll
        for (int d = 0; d < 2; ++d) {
          const size_t gt = d == 0 ? gt0 : gt1;
#pragma unroll
          for (int i = 0; i < 2; ++i) {
            int idx = tid + 256 * i;
            int tok = idx >> 3, cc = idx & 7;
            size_t g = gt + tok;
            partv[d][i] = *(const bf16x8*)(Y + g * EI + e0 + cc * 8);
            zv[d][i] = *(const bf16x8*)(ZB + g * EI + e0 + cc * 8);
          }
        }
      }
      __syncthreads();
#pragma unroll
      for (int d = 0; d < 2; ++d)
#pragma unroll
        for (int mb = 0; mb < 4; ++mb)
#pragma unroll
          for (int r = 0; r < 4; ++r) {
            int tok = mb * 16 + (lane >> 4) * 4 + r;
            float rg = sigmoidf_(ar[d][mb][r] + gbr[d]);
            float ig = sigmoidf_(ai[d][mb][r] + gbi[d]);
            float la = -8.f * rg * sp[d];
            float a = __expf(la);
            float x2 = -2.f * la;
            float poly = x2 * (1.f + x2 * (-0.5f + x2 * (0.16666667f + x2 * (-0.041666668f + x2 * (0.0083333338f + x2 * (-0.0013888889f))))));
            float om = x2 < 0.4f ? poly : 1.f - __expf(-x2);
            float u = __builtin_amdgcn_sqrtf(fmaxf(om, 0.f)) * (ig * bf2f(xfr[d][mb][r]));
            sA[d][tok][ch] = a;
            sU[d][tok][ch] = u;
          }
    }
    __syncthreads();
    if (tid < 128) {
#pragma unroll 1
      for (int c0 = 0; c0 < 64; c0 += 16) {
        float av[16], uv[16];
#pragma unroll
        for (int t = 0; t < 16; ++t) {
          const int tok = sd == 0 ? c0 + t : 63 - (c0 + t);
          av[t] = sA[sd][tok][sch];
          uv[t] = sU[sd][tok][sch];
        }
#pragma unroll
        for (int t = 0; t < 16; ++t) { hst = av[t] * hst + uv[t]; uv[t] = hst; }
#pragma unroll
        for (int t = 0; t < 16; ++t) {
          const int tok = sd == 0 ? c0 + t : 63 - (c0 + t);
          sU[sd][tok][sch] = uv[t];
        }
      }
    }
    __syncthreads();
#pragma unroll
    for (int d = 0; d < 2; ++d) {
      const int tile = d == 0 ? it : NT - 1 - it;
#pragma unroll
      for (int i = 0; i < 2; ++i) {
        int idx = tid + 256 * i;
        int tok = idx >> 3, cc = idx & 7;
        size_t g = g0 + (size_t)tile * 64 + tok;
        float4 y0 = *(const float4*)&sU[d][tok][cc * 8], y1 = *(const float4*)&sU[d][tok][cc * 8 + 4];
        float y[8] = {y0.x, y0.y, y0.z, y0.w, y1.x, y1.y, y1.z, y1.w};
        bf16_t* yp = Y + g * EI + e0 + cc * 8;
        if (first) {
          *(bf16x8*)yp = pack8bf(y[0], y[1], y[2], y[3], y[4], y[5], y[6], y[7]);
        } else {
          bf16x8 part = partv[d][i], z = zv[d][i];
          *(bf16x8*)yp = pack8bf((y[0] + bfs(part[0])) * bfs(z[0]), (y[1] + bfs(part[1])) * bfs(z[1]), (y[2] + bfs(part[2])) * bfs(z[2]),
                                 (y[3] + bfs(part[3])) * bfs(z[3]), (y[4] + bfs(part[4])) * bfs(z[4]), (y[5] + bfs(part[5])) * bfs(z[5]),
                                 (y[6] + bfs(part[6])) * bfs(z[6]), (y[7] + bfs(part[7])) * bfs(z[7]));
        }
      }
    }
    __syncthreads();
  }
  if (tid < 128 && s < 32) p.out[OFF_LRU + (size_t)((s * 2 + j) * 2 + sd) * EI + e0 + sch] = hst;
}
DEV void phase_lru_scan(const int wv, const Params& p, int j, char* smem) {
  const int tid = TID;
  const int G = gridDim.x, b = BID;
  int item, step;
  if (G >= 320) { if (b < 256) { item = b; step = 1 << 20; } else { item = b; step = G - 256; } }
  else { item = b; step = G; }
  for (; item < 2304; item += step) lru_item(p, j, item, smem, tid);
}

DEV void phase_mix(const int wv, const Params& p, int j) {
  const int tid = TID, bid = BID;
  const float* mu = p.mu + (size_t)j * 5 * DM;
  const size_t HALF = (size_t)TTOK * DM;
  bf16_t* dst[5] = {p.BA, p.BB + HALF, p.BA + HALF, p.BB, p.BC};
  for (int idx = bid * 256 + tid; idx < TTOK * 256; idx += gridDim.x * 256) {
    const int row = idx >> 8, k = (idx & 255) * 8;
    int srow; bool valid;
    if (row < TCTX) {
      int t = row & 255;
      if (k < 1024) { srow = row - 1; valid = t > 0; } else { srow = row + 1; valid = t < 255; }
    } else {
      int t = (row - TCTX) & 4095;
      int q = k >> 9;
      if (q == 0) { srow = row - 1; valid = (t & 63) != 0; }
      else if (q == 1) { srow = row + 1; valid = (t & 63) != 63; }
      else if (q == 2) { srow = row - 64; valid = t >= 64; }
      else { srow = row + 64; valid = t < 4096 - 64; }
    }
    bf16x8 hv = *(const bf16x8*)(p.H + (size_t)row * DM + k);
    bf16x8 sv = *(const bf16x8*)(p.H + (size_t)(valid ? srow : row) * DM + k);
    float h[8], dx[8];
#pragma unroll
    for (int i = 0; i < 8; ++i) { h[i] = bfs(hv[i]); dx[i] = valid ? bfs(sv[i]) - h[i] : -h[i]; }
#pragma unroll
    for (int m = 0; m < 5; ++m) {
      float4 m0 = *(const float4*)(mu + m * DM + k), m1 = *(const float4*)(mu + m * DM + k + 4);
      *(bf16x8*)(dst[m] + (size_t)row * DM + k) =
          pack8bf(h[0] + dx[0] * m0.x, h[1] + dx[1] * m0.y, h[2] + dx[2] * m0.z, h[3] + dx[3] * m0.w,
                  h[4] + dx[4] * m1.x, h[5] + dx[5] * m1.y, h[6] + dx[6] * m1.z, h[7] + dx[7] * m1.w);
    }
  }
}
DEV void phase_rwkv_ga(const int wv, const Params& p, int j, char* smem) {
  const int tid = TID, bid = BID;
  const size_t HALF = (size_t)TTOK * DM;
  const int T0 = (j == 0) ? MT * 16 : 0;
  const int nsmall = (j == 0) ? 4 : 5;
  const int total = T0 + MT * nsmall;
  for (int t = bid; t < total; t += gridDim.x) {
    if (t < T0) {
      int nt, mt; tile_map(t, 4, mt, nt);
      EpBF16 ep{p.VF, EI};
      gemm_tile_bt(p.BB, DM, p.WB, DM, mt * 128, nt * GBN, ep, smem, tid);
    } else {
      int loc = t - T0;
      int job = loc / MT, mt = loc % MT;
      const bf16_t* Aj; const float* Bj; int ldbj = 128, nvj = 128, tanhj = 0; bf16_t* Cj;
      if (job < 2) { Aj = p.BB + HALF; Bj = p.w1 + (size_t)(j * 2 + job) * DM * 128; Cj = p.LORA1 + job * 128; tanhj = 1; }
      else if (job < 4) { Aj = p.BC; Bj = p.a1 + (size_t)(j * 2 + (job - 2)) * DM * 128; Cj = p.LORA1 + 256 + (job - 2) * 128; }
      else { Aj = p.BB; Bj = p.v1; ldbj = 96; nvj = 96; Cj = p.LORA1 + 512; }
      ALPlain alj{Aj, DM};
      EpLora ep{Cj, tanhj};
      gemm_tile<true>(alj, Bj, ldbj, DM, nvj, DM, mt * 128, 0, ep, smem, tid);
    }
  }
}
DEV void phase_rwkv_gb(const int wv, const Params& p, char* smem) {
  const int tid = TID, bid = BID;
  ALPlain all{p.LORA1 + 512, 640};
  EpVmix ep1{p.BC, p.v0};
  EpVmixV ep2{p.VF, p.BC};
  for (int t = bid; t < MT * 16; t += gridDim.x) {
    int nt, mt; tile_map(t, 4, mt, nt);
    gemm_tile<true>(all, p.v2, EI, 96, EI, 128, mt * 128, nt * GBN, ep1, smem, tid);
    gemm_tile<true>(all, p.v2, EI, 96, EI, 128, mt * 128, nt * GBN + 128, ep1, smem, tid);
    __syncthreads();
    gemm_tile_bt(p.BB, DM, p.WB, DM, mt * 128, nt * GBN, ep2, smem, tid);
  }
}
DEV void phase_rwkv_gc(const int wv, const Params& p, int j, char* smem) {
  const int tid = TID, bid = BID;
  const size_t HALF = (size_t)TTOK * DM;
  EpBF16 epr{p.BB, EI}, epk{p.BC, EI};
  for (int t = bid; t < MT * 32; t += gridDim.x) {
    int job = t / (MT * 16), loc = t % (MT * 16);
    int nt, mt; tile_map(loc, 4, mt, nt);
    if (job == 0) gemm_tile_bt(p.BA, DM, p.WB + ((size_t)DM * EI), DM, mt * 128, nt * GBN, epr, smem, tid);
    else gemm_tile_bt(p.BA + HALF, DM, p.WB + 2 * ((size_t)DM * EI), DM, mt * 128, nt * GBN, epk, smem, tid);
  }
}
DEV void phase_rwkv_gz(const int wv, const Params& p, int j, char* smem) {
  const int tid = TID, bid = BID;
  EpZ ep{p.BA};
  for (int t = bid; t < MT * 16; t += gridDim.x) {
    int nt, mt; tile_map(t, 4, mt, nt);
    gemm_tile_bt(p.H, DM, p.WB, DM, mt * 128, nt * GBN, ep, smem, tid);
  }
}

DEV void rwkv_item(const Params& p, int j, int item, char* smem, const int tid) {
  const int lane = tid & 63, w = tid >> 6;
  const int d = w & 1;
  const bool producer = w >= 2;
  float* rec = (float*)smem;
  float* yout = rec + 12288;
  float* bsl = yout + 2048;
  const bf16_t* R = p.BB;
  const bf16_t* Kb = p.BC;
  const bf16_t* V = p.VF;
  bf16_t* Y = p.BA;
  int s, hd;
  if (item < 256) { s = 32 + (item >> 6); hd = item & 63; } else { s = (item - 256) >> 6; hd = (item - 256) & 63; }
  const int L = s < 32 ? 256 : 4096;
  const size_t g0 = s < 32 ? (size_t)s * 256 : (size_t)TCTX + (size_t)(s - 32) * 4096;
  const int NT = L >> 3;
  const int el = hd * 64 + lane;
  if (s >= 32) __builtin_amdgcn_s_setprio(3);

  if (!producer) {
    float S[64];
    if (s >= 32) {
      const float* sp = p.state_rwkv + ((size_t)((((s - 32) * 2 + j) * 2 + d) * 64 + hd)) * 4096 + lane * 64;
#pragma unroll
      for (int k = 0; k < 64; k += 4) { float4 v = *(const float4*)(sp + k); S[k] = v.x; S[k + 1] = v.y; S[k + 2] = v.z; S[k + 3] = v.w; }
    } else {
#pragma unroll
      for (int k = 0; k < 64; ++k) S[k] = 0.f;
    }
    const int l4 = (lane & 3) * 4;
#define DPP_FMAC(acc, x, sv, J) asm("v_fmac_f32_dpp %0, %1, %2 quad_perm:[" #J "," #J "," #J "," #J "] row_mask:0xf bank_mask:0xf" : "+v"(acc) : "v"(x), "v"(sv))
#define DPP_MULS(sv, x, J) asm("v_mul_f32_dpp %0, %1, %0 quad_perm:[" #J "," #J "," #J "," #J "] row_mask:0xf bank_mask:0xf" : "+v"(sv) : "v"(x))
#define UPD_E(C, k, comp, J)            \
  DPP_FMAC(S[k], C[0].comp, sa, J);     \
  DPP_FMAC(S[k], C[1].comp, vq, J);
#define UPD_Q(C, m, J)                    \
  UPD_E(C, 16 * (m) + 4 * (J) + 0, x, J)  \
  UPD_E(C, 16 * (m) + 4 * (J) + 1, y, J)  \
  UPD_E(C, 16 * (m) + 4 * (J) + 2, z, J)  \
  UPD_E(C, 16 * (m) + 4 * (J) + 3, w, J)
#define UPD_M(C, m) UPD_Q(C, m, 0) UPD_Q(C, m, 1) UPD_Q(C, m, 2) UPD_Q(C, m, 3)
#define DOT_M(acc0, acc1, V, m)                                                               \
  _Pragma("unroll") for (int cc = 0; cc < 4; ++cc) {                                          \
    acc0 += fl2_t{S[16 * (m) + 4 * cc], S[16 * (m) + 4 * cc + 1]} * fl2_t{V[cc].x, V[cc].y};  \
    acc1 += fl2_t{S[16 * (m) + 4 * cc + 2], S[16 * (m) + 4 * cc + 3]} * fl2_t{V[cc].z, V[cc].w}; \
  }
#define MUL_M(V, m)                                                                            \
  _Pragma("unroll") for (int cc = 0; cc < 4; ++cc) {                                          \
    fl2_t t0 = fl2_t{S[16 * (m) + 4 * cc], S[16 * (m) + 4 * cc + 1]} * fl2_t{V[cc].x, V[cc].y};  \
    fl2_t t1 = fl2_t{S[16 * (m) + 4 * cc + 2], S[16 * (m) + 4 * cc + 3]} * fl2_t{V[cc].z, V[cc].w}; \
    S[16 * (m) + 4 * cc] = t0.x; S[16 * (m) + 4 * cc + 1] = t0.y; S[16 * (m) + 4 * cc + 2] = t1.x; S[16 * (m) + 4 * cc + 3] = t1.y; \
  }
#define LOAD_V(V, base, m) _Pragma("unroll") for (int cc = 0; cc < 4; ++cc) V[cc] = *(const float4*)((base) + 16 * (m) + 4 * cc);
#define LOAD_C(C, vt, m)                         \
  C[0] = *(const float4*)((vt) + 128 + 16 * (m)); \
  C[1] = *(const float4*)((vt) + 192 + 16 * (m));
    __syncthreads();
    for (int i = 0; i <= NT; ++i) {
      if (i < NT) {
        const int b = i & 1;
        const float* ub0 = rec + ((b * 2 + d) * 8) * 384;
        float4 A0[4], A1[4], R0[4], W0[4], W1[4], C0[2], C1[2];
        LOAD_V(A0, ub0 + 64, 0)
        LOAD_V(A1, ub0 + 64, 1)
#pragma unroll 1
        for (int q = 0; q < 8; ++q) {
          const float* ub = ub0 + q * 384;
          const float* vt = ub + l4;
          const float vq = ub[320 + lane];
          fl2_t acc0 = {0.f, 0.f}, acc1 = {0.f, 0.f};
          __builtin_amdgcn_sched_barrier(0);
          LOAD_V(R0, ub + 64, 2)
          DOT_M(acc0, acc1, A0, 0)
          __builtin_amdgcn_sched_barrier(0);
          LOAD_V(A0, ub + 64, 3)
          DOT_M(acc0, acc1, A1, 1)
          __builtin_amdgcn_sched_barrier(0);
          LOAD_C(C0, vt, 0)
          LOAD_V(W0, ub, 0)
          DOT_M(acc0, acc1, R0, 2)
          __builtin_amdgcn_sched_barrier(0);
          LOAD_C(C1, vt, 1)
          LOAD_V(W1, ub, 1)
          LOAD_V(R0, ub + 256, 0)
          DOT_M(acc0, acc1, A0, 3)
          const float sa = (acc0.x + acc0.y) + (acc1.x + acc1.y);
          fl2_t y0 = {0.f, 0.f}, y1 = {0.f, 0.f};
          __builtin_amdgcn_sched_barrier(0);
          MUL_M(W0, 0)
          UPD_M(C0, 0)
          LOAD_C(C0, vt, 2)
          LOAD_V(W0, ub, 2)
          LOAD_V(A1, ub + 256, 1)
          DOT_M(y0, y1, R0, 0)
          __builtin_amdgcn_sched_barrier(0);
          MUL_M(W1, 1)
          UPD_M(C1, 1)
          LOAD_C(C1, vt, 3)
          LOAD_V(W1, ub, 3)
          LOAD_V(R0, ub + 256, 2)
          DOT_M(y0, y1, A1, 1)
          __builtin_amdgcn_sched_barrier(0);
          MUL_M(W0, 2)
          UPD_M(C0, 2)
          LOAD_V(A1, ub + 256, 3)
          DOT_M(y0, y1, R0, 2)
          __builtin_amdgcn_sched_barrier(0);
          MUL_M(W1, 3)
          UPD_M(C1, 3)
          LOAD_V(A0, ub + 384 + 64, 0)
          DOT_M(y0, y1, A1, 3)
          __builtin_amdgcn_sched_barrier(0);
          LOAD_V(A1, ub + 384 + 64, 1)
          yout[((b * 2 + d) * 8 + q) * 64 + lane] = (y0.x + y0.y) + (y1.x + y1.y);
        }
      }
      __syncthreads();
    }
#undef MUL_M
#undef DOT_M
#undef LOAD_V
#undef DPP_FMAC
#undef DPP_MULS
#undef UPD_E
#undef UPD_Q
#undef UPD_M
#undef LOAD_C
    if (s < 32) {
      float* dst = p.out + OFF_RWKV + ((size_t)(((s * 2 + j) * 2 + d) * 64 + hd)) * 4096 + lane * 64;
#pragma unroll
      for (int k = 0; k < 64; k += 4) *(float4*)(dst + k) = float4{S[k], S[k + 1], S[k + 2], S[k + 3]};
    }
  } else {
    const int hi = lane >> 5;
    const int c16 = lane & 15;
    const int qb = ((lane >> 4) & 1) * 4;
    float w0c[2], a0c[2], kkc[2], kac[2], rkc[2];
#pragma unroll
    for (int nbi = 0; nbi < 2; ++nbi) {
      const int e = hd * 64 + (hi * 2 + nbi) * 16 + c16;
      w0c[nbi] = p.w0[(size_t)(j * 2 + d) * EI + e];
      a0c[nbi] = p.a0[(size_t)(j * 2 + d) * EI + e];
      kkc[nbi] = p.k_k[(size_t)j * EI + e];
      kac[nbi] = p.k_a[(size_t)j * EI + e];
      rkc[nbi] = p.r_k[(size_t)j * EI + e];
    }
    const float lnw = p.ln_w[(size_t)j * EI + el];
    const float lnb = p.ln_b[(size_t)j * EI + el];
    const bf16_t* W2 = p.W2T + ((size_t)(j * 2 + d) * EI + hd * 64 + c16) * 128 + (lane >> 4) * 8;
    const bf16_t* A2 = p.A2T + ((size_t)(j * 2 + d) * EI + hd * 64 + c16) * 128 + (lane >> 4) * 8;
    float* BSme = p.BS + (size_t)d * TTOK * 64;
    const float* BSot = p.BS + (size_t)(1 - d) * TTOK * 64;

    auto tile_g = [&](int i, int q) -> size_t {
      return d == 0 ? g0 + (size_t)i * 8 + q : g0 + (size_t)(L - 1 - i * 8 - q);
    };
    bf16x8 xw[4], xa[4];
    unsigned short rr_[2][4], kx_[2][4], vv_[2][4];
    unsigned short ypart[8];
    float bso[8];
    auto prefetch_tile = [&](const int in) {
      const int inc = in < NT ? in : NT - 1;
      const bf16_t* Ap = p.LORA1 + tile_g(inc, lane & 7) * 640 + (lane >> 4) * 8;
#pragma unroll
      for (int ks = 0; ks < 4; ++ks) {
        xw[ks] = *(const bf16x8*)(Ap + d * 128 + ks * 32);
        xa[ks] = *(const bf16x8*)(Ap + 256 + d * 128 + ks * 32);
      }
    };
    auto load_part = [&](const int ip) {
#pragma unroll
      for (int q = 0; q < 8; ++q) {
        const size_t g = tile_g(ip, q);
        ypart[q] = Y[g * EI + el];
        bso[q] = BSot[g * 64 + hd];
      }
    };
    auto prod_iter = [&](const int ip, const int in) {
      const bool do_post = ip >= 0, do_prod = in < NT;
      const bool first = ip < (NT >> 1);
      if (do_post && !first) load_part(ip);
      bf16x8 bwA[4], baA[4];
#define LOAD_B(BW, BA_, ks)                                                  \
  _Pragma("unroll") for (int nb = 0; nb < 4; ++nb) {                         \
    BW[nb] = *(const bf16x8*)(W2 + (size_t)nb * 16 * 128 + (ks) * 32);       \
    BA_[nb] = *(const bf16x8*)(A2 + (size_t)nb * 16 * 128 + (ks) * 32);      \
  }
#define MFMA_B(BW, BA_, ks)                                                  \
  _Pragma("unroll") for (int nb = 0; nb < 4; ++nb) {                         \
    aw[nb] = __builtin_amdgcn_mfma_f32_16x16x32_bf16(xw[ks], BW[nb], aw[nb], 0, 0, 0);  \
    aa[nb] = __builtin_amdgcn_mfma_f32_16x16x32_bf16(xa[ks], BA_[nb], aa[nb], 0, 0, 0); \
  }
      if (do_prod) { LOAD_B(bwA, baA, 0) }
      __builtin_amdgcn_sched_barrier(0);
      if (do_post) {
        const int b = ip & 1;
#pragma unroll
        for (int q = 0; q < 8; ++q) {
          const size_t g = tile_g(ip, q);
          const float y = yout[((b * 2 + d) * 8 + q) * 64 + lane];
          const float bsq = bsl[(b * 2 + d) * 8 + q];
          if (first) {
            Y[g * EI + el] = f2bf(y);
            if (lane == 0) BSme[g * 64 + hd] = bsq;
          } else {
            const float vq = rec[((b * 2 + d) * 8 + q) * 384 + 320 + lane];
            const float yt = y + bf2f(ypart[q]);
            const float mean = wave_sum_fast(yt) * (1.f / 64.f);
            const float dv = yt - mean;
            const float var = wave_sum_fast(dv * dv) * (1.f / 64.f);
            const float yn = dv * __builtin_amdgcn_rsqf(var + 64e-5f) * lnw + lnb;
            Y[g * EI + el] = f2bf(yn + (bsq + bso[q]) * vq);
          }
        }
      }
      __builtin_amdgcn_sched_barrier(0);
      if (do_prod) {
        const int b = in & 1;
        f32x4 aw[4], aa[4];
#pragma unroll
        for (int nb = 0; nb < 4; ++nb) { aw[nb] = f32x4{0.f, 0.f, 0.f, 0.f}; aa[nb] = f32x4{0.f, 0.f, 0.f, 0.f}; }
#pragma unroll
        for (int nbi = 0; nbi < 2; ++nbi)
#pragma unroll
          for (int r = 0; r < 4; ++r) {
            const size_t g = tile_g(in, qb + r);
            const int e = hd * 64 + (hi * 2 + nbi) * 16 + c16;
            rr_[nbi][r] = R[g * EI + e];
            kx_[nbi][r] = Kb[g * EI + e];
            vv_[nbi][r] = V[g * EI + e];
          }
        MFMA_B(bwA, baA, 0)
        __builtin_amdgcn_sched_barrier(0);
        LOAD_B(bwA, baA, 1)
        MFMA_B(bwA, baA, 1)
        __builtin_amdgcn_sched_barrier(0);
        LOAD_B(bwA, baA, 2)
        MFMA_B(bwA, baA, 2)
        __builtin_amdgcn_sched_barrier(0);
        LOAD_B(bwA, baA, 3)
        MFMA_B(bwA, baA, 3)
        float dec[2][4], asg[2][4], kk[2][4], kd[2][4], rr[2][4], vv[2][4], ss[4], bs[4];
#pragma unroll
        for (int r = 0; r < 4; ++r) { ss[r] = 0.f; bs[r] = 0.f; }
#pragma unroll
        for (int nbi = 0; nbi < 2; ++nbi)
#pragma unroll
          for (int r = 0; r < 4; ++r) {
            const float wacc = hi ? aw[2 + nbi][r] : aw[nbi][r];
            const float aacc = hi ? aa[2 + nbi][r] : aa[nbi][r];
            dec[nbi][r] = __expf(-0.6065306597126334f * sigmoidf_(wacc + w0c[nbi]));
            asg[nbi][r] = sigmoidf_(aacc + a0c[nbi]);
            rr[nbi][r] = bf2f(rr_[nbi][r]);
            const float kx = bf2f(kx_[nbi][r]);
            vv[nbi][r] = bf2f(vv_[nbi][r]);
            kk[nbi][r] = kx * kkc[nbi];
            ss[r] += kk[nbi][r] * kk[nbi][r];
            kd[nbi][r] = kx * (1.f + (asg[nbi][r] - 1.f) * kac[nbi]);
            bs[r] += rr[nbi][r] * kd[nbi][r] * rkc[nbi];
          }
        {
          const bool qhi = (lane >> 4) & 1;
#pragma unroll
          for (int r = 0; r < 4; ++r) {
            float a = row_sum16(ss[r]);
            float c = row_sum16(bs[r]);
            float a0 = rdlane(a, 0) + rdlane(a, 32), a1 = rdlane(a, 16) + rdlane(a, 48);
            float c0 = rdlane(c, 0) + rdlane(c, 32), c1 = rdlane(c, 16) + rdlane(c, 48);
            ss[r] = qhi ? a1 : a0;
            bs[r] = qhi ? c1 : c0;
          }
        }
#pragma unroll
        for (int r = 0; r < 4; ++r) {
          const float inv = __builtin_amdgcn_rcpf(fmaxf(__builtin_amdgcn_sqrtf(ss[r]), 1e-12f));
          float* vt = rec + ((b * 2 + d) * 8 + qb + r) * 384;
#pragma unroll
          for (int nbi = 0; nbi < 2; ++nbi) {
            const int ch = (hi * 2 + nbi) * 16 + c16;
            const float kn = kk[nbi][r] * inv;
            vt[ch] = dec[nbi][r];
            vt[64 + ch] = -kn;
            vt[128 + ch] = kn * asg[nbi][r];
            vt[192 + ch] = kd[nbi][r];
            vt[256 + ch] = rr[nbi][r];
            vt[320 + ch] = vv[nbi][r];
          }
          if ((lane & 47) == 0) bsl[(b * 2 + d) * 8 + qb + r] = bs[r];
        }
      }
#undef LOAD_B
#undef MFMA_B
      prefetch_tile(in + 1);
    };
    prefetch_tile(0);
    prod_iter(-1, 0);
    __syncthreads();
    for (int i = 0; i <= NT; ++i) {
      prod_iter(i - 1, i + 1);
      __syncthreads();
    }
  }
  __builtin_amdgcn_s_setprio(0);
  __syncthreads();
}
DEV void phase_rwkv_scan(const int wv, const Params& p, int j, char* smem) {
  const int tid = TID;
  const int G = gridDim.x, b = BID;
  int item, step;
  if (G >= 320) { if (b < 256) { item = b; step = 1 << 20; } else { item = b; step = G - 256; } }
  else { item = b; step = G; }
  for (; item < 2304; item += step) rwkv_item(p, j, item, smem, tid);
  if (G >= 320) {
    if (b >= 256) {
      convert_wt(p.w_g + (size_t)j * DM * EI, DM, EI, p.WB, b - 256, G - 256, smem, tid);
      convert_wt(p.w_o + (size_t)j * EI * DM, EI, DM, p.WB + ((size_t)DM * EI), b - 256, G - 256, smem, tid);
    }
  } else {
    convert_wt(p.w_g + (size_t)j * DM * EI, DM, EI, p.WB, b, G, smem, tid);
    convert_wt(p.w_o + (size_t)j * EI * DM, EI, DM, p.WB + ((size_t)DM * EI), b, G, smem, tid);
  }
}

DEV void fast_barrier(unsigned* bar, const unsigned k) {
  asm volatile("s_waitcnt vmcnt(0)" ::: "memory");
  __syncthreads();
  if (threadIdx.x == 0) {
    __builtin_amdgcn_fence(__ATOMIC_RELEASE, "agent");
    asm volatile("s_waitcnt vmcnt(0)" ::: "memory");
    const unsigned G = gridDim.x;
    const unsigned g = blockIdx.x & 15u;
    const unsigned ng = (G - g + 15u) >> 4;
    const unsigned ngroups = G < 16u ? G : 16u;
    unsigned* grp_cnt = bar + 64 * g;
    unsigned* grp_gen = bar + 64 * (16 + g);
    unsigned* top_cnt = bar + 64 * 32;
    const unsigned old = __hip_atomic_fetch_add(grp_cnt, 1u, __ATOMIC_RELAXED, __HIP_MEMORY_SCOPE_AGENT);
    if (old + 1u == k * ng) {
      const unsigned oldt = __hip_atomic_fetch_add(top_cnt, 1u, __ATOMIC_RELAXED, __HIP_MEMORY_SCOPE_AGENT);
      if (oldt + 1u == k * ngroups) {
        for (unsigned gg = 0; gg < ngroups; ++gg) __hip_atomic_store(bar + 64 * (16 + gg), k, __ATOMIC_RELAXED, __HIP_MEMORY_SCOPE_AGENT);
      }
    }
    unsigned sp = 0;
    while (__hip_atomic_load(grp_gen, __ATOMIC_RELAXED, __HIP_MEMORY_SCOPE_AGENT) < k) {
      __builtin_amdgcn_s_sleep(1);
      if (++sp > (1u << 24)) break;
    }
    __builtin_amdgcn_fence(__ATOMIC_ACQUIRE, "agent");
    asm volatile("s_waitcnt vmcnt(0)" ::: "memory");
  }
  __syncthreads();
}

__global__ void __launch_bounds__(256, 2) mega_kernel(Params p) {
  __shared__ __attribute__((aligned(16))) char smem[69632];
  cg::grid_group grid = cg::this_grid();
  unsigned nbar = 0;
  const int wv = __builtin_amdgcn_readfirstlane((int)(threadIdx.x >> 6));
  phase_prep(wv, p, smem);
  grid.sync();
#pragma unroll 1
  for (int layer = 0; layer < 4; ++layer) {
    phase_row(wv, p, layer, smem);
    fast_barrier(p.BAR, ++nbar);
    const int j = layer >> 1;
    if ((layer & 1) == 0) {
      phase_lru_in(wv, p, j, smem);
      fast_barrier(p.BAR, ++nbar);
      phase_conv(wv, p, j, smem);
      fast_barrier(p.BAR, ++nbar);
      phase_lru_scan(wv, p, j, smem);
      fast_barrier(p.BAR, ++nbar);
      phase_out_proj(wv, p, p.BA, p.WB + ((size_t)DM * EI), (float*)p.BC, smem);
      fast_barrier(p.BAR, ++nbar);
    } else {
      phase_mix(wv, p, j);
      fast_barrier(p.BAR, ++nbar);
      phase_rwkv_ga(wv, p, j, smem);
      fast_barrier(p.BAR, ++nbar);
      if (j == 1) { phase_rwkv_gb(wv, p, smem); fast_barrier(p.BAR, ++nbar); }
      phase_rwkv_gc(wv, p, j, smem);
      fast_barrier(p.BAR, ++nbar);
      phase_rwkv_scan(wv, p, j, smem);
      fast_barrier(p.BAR, ++nbar);
      phase_rwkv_gz(wv, p, j, smem);
      fast_barrier(p.BAR, ++nbar);
      phase_out_proj(wv, p, p.BA, p.WB + ((size_t)DM * EI), (float*)p.BB, smem);
      fast_barrier(p.BAR, ++nbar);
    }
  }
  phase_row(wv, p, 4, smem);
}

extern "C" void kernel_launch(void* const* d_in, const int* in_sizes, int n_in, void* d_out, int out_size, void* d_ws, size_t ws_size,
                              hipStream_t stream) {
  static int grid_blocks = 0;
  if (!grid_blocks) {
    int dev = 0, cus = 0, per_cu = 0;
    hipGetDevice(&dev);
    hipDeviceGetAttribute(&cus, hipDeviceAttributeMultiprocessorCount, dev);
    hipOccupancyMaxActiveBlocksPerMultiprocessor(&per_cu, (const void*)mega_kernel, 256, 0);
    if (per_cu > 2) per_cu = 2;
    if (per_cu < 1) per_cu = 1;
    grid_blocks = cus * per_cu;
  }
  Params p{};
  const float* const* in = (const float* const*)d_in;
  p.x_prompt = in[0]; p.x_sample = in[1]; p.state_lru = in[2]; p.state_rwkv = in[3]; p.c = in[4]; p.c_ctx = in[5];
  p.ada_w = in[6]; p.ada_b = in[7]; p.norm_pre = in[8]; p.norm_post = in[9];
  p.lru_w_in = in[10]; p.lru_conv_w = in[11]; p.lru_conv_b = in[12]; p.lru_gate_w = in[13]; p.lru_gate_b = in[14];
  p.lru_lambda = in[15]; p.lru_w_out = in[16];
  p.mu = in[17]; p.w_r = in[18]; p.w_k = in[19]; p.w_v = in[20]; p.w_g = in[21]; p.w_o = in[22];
  p.w0 = in[23]; p.w1 = in[24]; p.w2 = in[25]; p.a0 = in[26]; p.a1 = in[27]; p.a2 = in[28];
  p.k_k = in[29]; p.k_a = in[30]; p.r_k = in[31]; p.ln_w = in[32]; p.ln_b = in[33]; p.v0 = in[34]; p.v1 = in[35]; p.v2 = in[36];
  p.out = (float*)d_out;
  char* ws = (char*)d_ws;
  size_t off = 0;
  auto take = [&](size_t bytes) { char* r = ws + off; off += (bytes + 255) & ~(size_t)255; return r; };
  p.MOD = (float*)take(4 * 5 * 6144 * 4);
  p.W2T = (bf16_t*)take((size_t)4 * 4096 * 128 * 2);
  p.A2T = (bf16_t*)take((size_t)4 * 4096 * 128 * 2);
  p.H = (bf16_t*)take((size_t)TTOK * DM * 2);
  p.BA = (bf16_t*)take((size_t)TTOK * EI * 2);
  p.BB = (bf16_t*)take((size_t)TTOK * EI * 2);
  p.BC = (bf16_t*)take((size_t)TTOK * EI * 2);
  p.VF = (bf16_t*)take((size_t)TTOK * EI * 2);
  p.LORA1 = (bf16_t*)take((size_t)TTOK * 640 * 2);
  p.BS = (float*)take((size_t)2 * TTOK * 64 * 4);
  p.WB = (bf16_t*)take((size_t)3 * DM * EI * 2);
  p.BAR = (unsigned*)take(16384);
  if (off > ws_size) { fprintf(stderr, "workspace too small: need %zu have %zu\n", off, ws_size); return; }
  hipMemsetAsync(p.BAR, 0, 16384, stream);
  void* args[] = {&p};
  hipError_t e = hipLaunchCooperativeKernel((const void*)mega_kernel, dim3(grid_blocks), dim3(256), args, 0, stream);
  if (e != hipSuccess) fprintf(stderr, "cooperative launch failed: %s (grid %d)\n", hipGetErrorString(e), grid_blocks);
}
```

```cpp
#include <hip/hip_runtime.h>
#include <hip/hip_cooperative_groups.h>
#include <stdint.h>
#include <stdio.h>
namespace cg = cooperative_groups;

#define DEV __device__ __forceinline__

typedef unsigned short bf16_t;
using bf16x8 = __attribute__((ext_vector_type(8))) short;
using f32x4 = __attribute__((ext_vector_type(4))) float;

static constexpr int DM = 2048;
static constexpr int EI = 4096;
static constexpr int TCTX = 8192;
static constexpr int TTOK = 24576;
static constexpr size_t OFF_LRU = 50331648ull;
static constexpr size_t OFF_RWKV = 50855936ull;

struct Params {
  const float *x_prompt, *x_sample, *state_lru, *state_rwkv, *c, *c_ctx, *ada_w, *ada_b, *norm_pre, *norm_post;
  const float *lru_w_in, *lru_conv_w, *lru_conv_b, *lru_gate_w, *lru_gate_b, *lru_lambda, *lru_w_out;
  const float *mu, *w_r, *w_k, *w_v, *w_g, *w_o, *w0, *w1, *w2, *a0, *a1, *a2, *k_k, *k_a, *r_k, *ln_w, *ln_b, *v0, *v1, *v2;
  float* out;
  float* MOD;
  bf16_t* WB;
  bf16_t* W2T;
  bf16_t* A2T;
  bf16_t* H;
  bf16_t* BA;
  bf16_t* BB;
  bf16_t* BC;
  bf16_t* VF;
  bf16_t* LORA1;
  float* BS;
  unsigned* BAR;
};

DEV bf16_t f2bf(float f) {
  uint32_t u = __float_as_uint(f);
  u += 0x7fffu + ((u >> 16) & 1u);
  return (bf16_t)(u >> 16);
}
DEV float bf2f(bf16_t h) { return __uint_as_float(((uint32_t)h) << 16); }
DEV float bfs(short h) { return __uint_as_float(((uint32_t)(unsigned short)h) << 16); }
DEV float rcpf_(float x) { return __builtin_amdgcn_rcpf(x); }
DEV float sigmoidf_(float x) { return rcpf_(1.f + __expf(-x)); }
DEV float siluf_(float x) { return x * rcpf_(1.f + __expf(-x)); }
DEV float wave_sum(float v) {
#pragma unroll
  for (int o = 32; o > 0; o >>= 1) v += __shfl_xor(v, o, 64);
  return v;
}
typedef __bf16 bf2_t __attribute__((ext_vector_type(2)));
typedef float fl2_t __attribute__((ext_vector_type(2)));
DEV uint32_t pack2bf(float a, float b) {
  fl2_t v = {a, b};
  bf2_t r = __builtin_convertvector(v, bf2_t);
  return *(uint32_t*)&r;
}
DEV bf16x8 pack8bf(float a0, float a1, float a2, float a3, float a4, float a5, float a6, float a7) {
  union { uint32_t u[4]; bf16x8 v; } x;
  x.u[0] = pack2bf(a0, a1); x.u[1] = pack2bf(a2, a3); x.u[2] = pack2bf(a4, a5); x.u[3] = pack2bf(a6, a7);
  return x.v;
}
DEV int opq(int v) { asm volatile("" : "+v"(v)); return v; }
DEV int opqs(int v) { asm volatile("" : "+s"(v)); return v; }
DEV int lane_id_() { return (int)__builtin_amdgcn_mbcnt_hi(~0u, __builtin_amdgcn_mbcnt_lo(~0u, 0u)); }
#define TID opq(wv * 64 + lane_id_())
#define BID opqs((int)blockIdx.x)
template <int CTRL>
DEV float dpp_f(float x) {
  int xi = __builtin_bit_cast(int, x);
  return __builtin_bit_cast(float, __builtin_amdgcn_update_dpp(xi, xi, CTRL, 0xf, 0xf, true));
}
DEV float row_sum16(float x) {
  x += dpp_f<0xB1>(x);
  x += dpp_f<0x4E>(x);
  x += dpp_f<0x124>(x);
  x += dpp_f<0x128>(x);
  return x;
}
DEV float rdlane(float x, int l) { return __builtin_bit_cast(float, __builtin_amdgcn_readlane(__builtin_bit_cast(int, x), l)); }
DEV float wave_sum_fast(float x) {
  x = row_sum16(x);
  return (rdlane(x, 0) + rdlane(x, 16)) + (rdlane(x, 32) + rdlane(x, 48));
}
DEV void store4bf(bf16_t* p, f32x4 v) {
  uint2 u;
  u.x = pack2bf(v[0], v[1]);
  u.y = pack2bf(v[2], v[3]);
  *(uint2*)p = u;
}
DEV f32x4 load4bf(const bf16_t* p) {
  uint2 u = *(const uint2*)p;
  f32x4 v;
  v[0] = __uint_as_float(u.x << 16);
  v[1] = __uint_as_float(u.x & 0xffff0000u);
  v[2] = __uint_as_float(u.y << 16);
  v[3] = __uint_as_float(u.y & 0xffff0000u);
  return v;
}

DEV void transpose_tile(const float* __restrict__ in, int ldin, bf16_t* __restrict__ out, int ldout, int r0, int c0, char* smem, int tid) {
  float (*t)[65] = (float (*)[65])smem;
  float4 v[4];
#pragma unroll
  for (int i = 0; i < 4; ++i) {
    int idx = tid + 256 * i;
    int r = idx >> 4, c4 = (idx & 15) * 4;
    v[i] = *(const float4*)(in + (size_t)(r0 + r) * ldin + c0 + c4);
  }
#pragma unroll
  for (int i = 0; i < 4; ++i) {
    int idx = tid + 256 * i;
    int r = idx >> 4, c4 = (idx & 15) * 4;
    t[r][c4] = v[i].x; t[r][c4 + 1] = v[i].y; t[r][c4 + 2] = v[i].z; t[r][c4 + 3] = v[i].w;
  }
  __syncthreads();
  uint32_t o[8];
#pragma unroll
  for (int i = 0; i < 8; ++i) {
    int idx = tid + 256 * i;
    int cc = idx >> 5, rp = idx & 31;
    o[i] = pack2bf(t[2 * rp][cc], t[2 * rp + 1][cc]);
  }
#pragma unroll
  for (int i = 0; i < 8; ++i) {
    int idx = tid + 256 * i;
    int cc = idx >> 5, rp = idx & 31;
    *(uint32_t*)(out + (size_t)(c0 + cc) * ldout + r0 + 2 * rp) = o[i];
  }
  __syncthreads();
}

DEV void transpose_tiles4(const float* const (&in)[4], const size_t (&rc)[4], int ldin, bf16_t* const (&out)[4], const size_t (&oc)[4], int ldout,
                          int nvalid, char* smem, int tid) {
  float (*t)[64][65] = (float (*)[64][65])smem;
  float4 v[4][4];
#pragma unroll
  for (int q = 0; q < 4; ++q)
    if (q < nvalid) {
#pragma unroll
      for (int i = 0; i < 4; ++i) {
        int idx = tid + 256 * i;
        int r = idx >> 4, c4 = (idx & 15) * 4;
        v[q][i] = *(const float4*)(in[q] + rc[q] + (size_t)r * ldin + c4);
      }
    }
#pragma unroll
  for (int q = 0; q < 4; ++q)
    if (q < nvalid) {
#pragma unroll
      for (int i = 0; i < 4; ++i) {
        int idx = tid + 256 * i;
        int r = idx >> 4, c4 = (idx & 15) * 4;
        t[q][r][c4] = v[q][i].x; t[q][r][c4 + 1] = v[q][i].y; t[q][r][c4 + 2] = v[q][i].z; t[q][r][c4 + 3] = v[q][i].w;
      }
    }
  __syncthreads();
#pragma unroll
  for (int q = 0; q < 4; ++q)
    if (q < nvalid) {
#pragma unroll
      for (int i = 0; i < 8; ++i) {
        int idx = tid + 256 * i;
        int cc = idx >> 5, rp = idx & 31;
        *(uint32_t*)(out[q] + oc[q] + (size_t)cc * ldout + 2 * rp) = pack2bf(t[q][2 * rp][cc], t[q][2 * rp + 1][cc]);
      }
    }
  __syncthreads();
}

DEV void convert_wt(const float* W, int K, int N, bf16_t* WT, int worker, int nworkers, char* smem, int tid);
DEV void phase_prep(const int wv, const Params& p, char* smem) {
  float* sc = (float*)smem;
  float* red = sc + 5 * 2048;
  const int tid = TID, bid = BID;
  for (int i = tid; i < 5 * 2048; i += 256) {
    int c = i >> 11, k = i & 2047;
    float v = (c == 0) ? p.c_ctx[k] : p.c[(c - 1) * 2048 + k];
    sc[i] = siluf_(v);
  }
  __syncthreads();
  int cq = tid & 7, kl = tid >> 3;
  for (int item = bid; item < 768; item += gridDim.x) {
    int l = item / 192, cgp = item % 192;
    int c0 = cgp * 32;
    const float* W = p.ada_w + (size_t)l * 2048 * 6144 + c0 + cq * 4;
    float acc[5][4];
#pragma unroll
    for (int c = 0; c < 5; ++c)
#pragma unroll
      for (int q = 0; q < 4; ++q) acc[c][q] = 0.f;
#pragma unroll 4
    for (int k = kl; k < 2048; k += 32) {
      float4 w4 = *(const float4*)(W + (size_t)k * 6144);
#pragma unroll
      for (int c = 0; c < 5; ++c) {
        float s = sc[c * 2048 + k];
        acc[c][0] += s * w4.x; acc[c][1] += s * w4.y; acc[c][2] += s * w4.z; acc[c][3] += s * w4.w;
      }
    }
    float* r = red + (kl * 8 + cq) * 20;
#pragma unroll
    for (int c = 0; c < 5; ++c)
#pragma unroll
      for (int q = 0; q < 4; ++q) r[c * 4 + q] = acc[c][q];
    __syncthreads();
    if (tid < 160) {
      int c = tid >> 5, col = tid & 31;
      float s = 0.f;
      for (int kk = 0; kk < 32; ++kk) s += red[(kk * 8 + (col >> 2)) * 20 + c * 4 + (col & 3)];
      p.MOD[(size_t)(l * 5 + c) * 6144 + c0 + col] = s + p.ada_b[l * 6144 + c0 + col];
    }
    __syncthreads();
  }
  for (int item = bid; item < 1024; item += gridDim.x) {
    int which = item >> 9;
    int rem = item & 511;
    int mat = rem >> 7, tl = rem & 127;
    const float* src = (which == 0 ? p.w2 : p.a2) + (size_t)mat * 128 * 4096;
    bf16_t* dst = (which == 0 ? p.W2T : p.A2T) + (size_t)mat * 4096 * 128;
    transpose_tile(src, 4096, dst, 128, (tl & 1) * 64, (tl >> 1) * 64, smem, tid);
  }
}

DEV void phase_row(const int wv, const Params& p, int layer, char* smem) {
  const int tid = TID, bid = BID;
  int lane = tid & 63, w = tid >> 6;
  for (int g = bid * 4 + w; g < TTOK; g += gridDim.x * 4) {
    int c = g < TCTX ? 0 : 1 + ((g - TCTX) >> 12);
    const float* xin;
    if (layer <= 1) xin = g < TCTX ? p.x_prompt + (size_t)g * DM : p.x_sample + (size_t)(g - TCTX) * DM;
    else xin = p.out + (size_t)g * DM;
    float4 x[8];
#pragma unroll
    for (int q = 0; q < 8; ++q) x[q] = ((const float4*)xin)[q * 64 + lane];
    if (layer > 0) {
      const float* M = (const float*)(((layer - 1) & 1) == 0 ? p.BC : p.BB) + (size_t)g * DM;
      float4 m[8];
      float ss = 0.f;
#pragma unroll
      for (int q = 0; q < 8; ++q) {
        m[q] = ((const float4*)M)[q * 64 + lane];
        ss += m[q].x * m[q].x + m[q].y * m[q].y + m[q].z * m[q].z + m[q].w * m[q].w;
      }
      ss = wave_sum_fast(ss);
      float rs = __builtin_amdgcn_rsqf(ss * (1.f / 2048.f) + 1e-6f);
      const float4* gate = (const float4*)(p.MOD + (size_t)((layer - 1) * 5 + c) * 6144 + 4096);
      const float4* np = (const float4*)(p.norm_post + (layer - 1) * DM);
#pragma unroll
      for (int q = 0; q < 8; ++q) {
        float4 gt = gate[q * 64 + lane], nn = np[q * 64 + lane];
        x[q].x += gt.x * (m[q].x * rs * nn.x);
        x[q].y += gt.y * (m[q].y * rs * nn.y);
        x[q].z += gt.z * (m[q].z * rs * nn.z);
        x[q].w += gt.w * (m[q].w * rs * nn.w);
        ((float4*)(p.out + (size_t)g * DM))[q * 64 + lane] = x[q];
      }
    }
    if (layer < 4) {
      float ss = 0.f;
#pragma unroll
      for (int q = 0; q < 8; ++q) ss += x[q].x * x[q].x + x[q].y * x[q].y + x[q].z * x[q].z + x[q].w * x[q].w;
      ss = wave_sum_fast(ss);
      float rs = __builtin_amdgcn_rsqf(ss * (1.f / 2048.f) + 1e-6f);
      const float4* sh = (const float4*)(p.MOD + (size_t)(layer * 5 + c) * 6144);
      const float4* scl = (const float4*)(p.MOD + (size_t)(layer * 5 + c) * 6144 + 2048);
      const float4* np = (const float4*)(p.norm_pre + layer * DM);
#pragma unroll
      for (int q = 0; q < 8; ++q) {
        float4 s1 = sh[q * 64 + lane], s2 = scl[q * 64 + lane], nn = np[q * 64 + lane];
        f32x4 h;
        h[0] = x[q].x * rs * nn.x * (1.f + s2.x) + s1.x;
        h[1] = x[q].y * rs * nn.y * (1.f + s2.y) + s1.y;
        h[2] = x[q].z * rs * nn.z * (1.f + s2.z) + s1.z;
        h[3] = x[q].w * rs * nn.w * (1.f + s2.w) + s1.w;
        store4bf(p.H + (size_t)g * DM + (q * 64 + lane) * 4, h);
      }
    }
  }
  if (layer < 4) {
    const int j = layer >> 1;
    const int G = gridDim.x;
    if ((layer & 1) == 0) {
      for (int it0 = bid; it0 < 1024; it0 += 4 * G) {
        const float* in[4]; bf16_t* out[4]; size_t rc[4], oc[4];
        int nvalid = 0;
#pragma unroll
        for (int q = 0; q < 4; ++q) {
          const int item = it0 + q * G;
          const int ic = item < 1024 ? item : it0;
          const int mat = ic >> 4, tl = ic & 15;
          in[q] = p.lru_gate_w + (size_t)(j * 64 + mat) * 65536;
          out[q] = p.WB + (size_t)mat * 65536;
          rc[q] = (size_t)((tl >> 2) * 64) * 256 + (tl & 3) * 64;
          oc[q] = (size_t)((tl & 3) * 64) * 256 + (tl >> 2) * 64;
          nvalid += (item < 1024) ? 1 : 0;
        }
        transpose_tiles4(in, rc, 256, out, oc, 256, nvalid, smem, tid);
      }
      convert_wt(p.lru_w_in + (size_t)j * DM * 8192, DM, 8192, p.WB + ((size_t)DM * EI), bid, G, smem, tid);
    } else {
      convert_wt(p.w_v + (size_t)j * DM * EI, DM, EI, p.WB, bid, G, smem, tid);
      convert_wt(p.w_r + (size_t)j * DM * EI, DM, EI, p.WB + ((size_t)DM * EI), bid, G, smem, tid);
      convert_wt(p.w_k + (size_t)j * DM * EI, DM, EI, p.WB + 2 * ((size_t)DM * EI), bid, G, smem, tid);
    }
  }
}

struct ALPlain {
  const bf16_t* p;
  int ld;
  struct Raw { bf16x8 v; };
  DEV void prep(int k) {}
  DEV void fetch(int row, int k, Raw& r) const { r.v = *(const bf16x8*)(p + (size_t)row * ld + k); }
  DEV bf16x8 finish(const Raw& r) const { return r.v; }
};
struct EpBF16 {
  bf16_t* C; int ldc;
  DEV void operator()(int m, int n, f32x4 v) const { store4bf(C + (size_t)m * ldc + n, v); }
};
struct EpXZ {
  bf16_t* X; bf16_t* Z;
  DEV void operator()(int m, int n, f32x4 v) const {
    if (n < EI) store4bf(X + (size_t)m * EI + n, v);
    else {
      f32x4 s;
#pragma unroll
      for (int i = 0; i < 4; ++i) s[i] = siluf_(v[i]);
      store4bf(Z + (size_t)m * EI + (n - EI), s);
    }
  }
};
struct EpF32 {
  float* C; int ldc;
  DEV void operator()(int m, int n, f32x4 v) const { *(f32x4*)(C + (size_t)m * ldc + n) = v; }
};
struct EpLora {
  bf16_t* C; int do_tanh;
  DEV void operator()(int m, int n, f32x4 v) const {
    if (do_tanh) {
#pragma unroll
      for (int i = 0; i < 4; ++i) { float xc = fminf(fmaxf(v[i], -15.f), 15.f); v[i] = 1.f - 2.f * rcpf_(1.f + __expf(2.f * xc)); }
    }
    store4bf(C + (size_t)m * 640 + n, v);
  }
};
struct EpVmix {
  bf16_t* C; const float* v0;
  DEV void operator()(int m, int n, f32x4 v) const {
    f32x4 b = *(const f32x4*)(v0 + n);
#pragma unroll
    for (int i = 0; i < 4; ++i) v[i] = sigmoidf_(v[i] + b[i]);
    store4bf(C + (size_t)m * EI + n, v);
  }
};
struct EpVmixV {
  bf16_t* VFp; const bf16_t* MIX;
  DEV void operator()(int m, int n, f32x4 v) const {
    f32x4 vf = load4bf(VFp + (size_t)m * EI + n);
    f32x4 mx = load4bf(MIX + (size_t)m * EI + n);
#pragma unroll
    for (int i = 0; i < 4; ++i) v[i] = v[i] + (vf[i] - v[i]) * mx[i];
    store4bf(VFp + (size_t)m * EI + n, v);
  }
};
struct EpZ {
  bf16_t* Y;
  DEV void operator()(int m, int n, f32x4 v) const {
    f32x4 y = load4bf(Y + (size_t)m * EI + n);
#pragma unroll
    for (int i = 0; i < 4; ++i) y[i] = y[i] * siluf_(v[i]);
    store4bf(Y + (size_t)m * EI + n, y);
  }
};

template <bool CHK, class AL, class EP>
DEV void gemm_tile(AL al, const float* __restrict__ Bp, int ldb, int Kv, int Nv, int K, int m0, int n0, const EP& ep, char* smem, const int tid) {
  bf16_t (*As)[80] = (bf16_t (*)[80])smem;
  bf16_t (*Bs)[80] = (bf16_t (*)[80])(smem + 128 * 80 * 2);
  const int lane = tid & 63, w = tid >> 6, wm = w >> 1, wn = w & 1;
  f32x4 acc[4][4];
#pragma unroll
  for (int i = 0; i < 4; ++i)
#pragma unroll
    for (int j = 0; j < 4; ++j) acc[i][j] = f32x4{0.f, 0.f, 0.f, 0.f};
  typename AL::Raw ra[4];
  float4 rb[8];
  const int arow = tid >> 3, akc = (tid & 7) * 8;
  const int bkg = tid >> 5, bnq = tid & 31;
  const int nk = K >> 6;
  const int bn = n0 + bnq * 4;

  const bool nok = bn < Nv;
  const int bnc = nok ? bn : 0;
  auto fetch = [&](int kt) {
#pragma unroll
    for (int i = 0; i < 4; ++i) al.fetch(m0 + arow + 32 * i, kt * 64 + akc, ra[i]);
    const int k0 = kt * 64 + bkg * 8;
    const bool ok = CHK ? (nok && (k0 < Kv)) : true;
    const float* bp = Bp + (size_t)(ok ? k0 : 0) * ldb + bnc;
#pragma unroll
    for (int i = 0; i < 8; ++i) {
      float4 v = *(const float4*)bp;
      bp += ldb;
      rb[i] = ok ? v : float4{0.f, 0.f, 0.f, 0.f};
    }
  };
  fetch(0);
  for (int kt = 0; kt < nk; ++kt) {
    al.prep(kt * 64 + akc);
#pragma unroll
    for (int i = 0; i < 4; ++i) *(bf16x8*)&As[arow + 32 * i][akc] = al.finish(ra[i]);
    {
      bf16x8 v0 = pack8bf(rb[0].x, rb[1].x, rb[2].x, rb[3].x, rb[4].x, rb[5].x, rb[6].x, rb[7].x);
      bf16x8 v1 = pack8bf(rb[0].y, rb[1].y, rb[2].y, rb[3].y, rb[4].y, rb[5].y, rb[6].y, rb[7].y);
      bf16x8 v2 = pack8bf(rb[0].z, rb[1].z, rb[2].z, rb[3].z, rb[4].z, rb[5].z, rb[6].z, rb[7].z);
      bf16x8 v3 = pack8bf(rb[0].w, rb[1].w, rb[2].w, rb[3].w, rb[4].w, rb[5].w, rb[6].w, rb[7].w);
      *(bf16x8*)&Bs[bnq * 4 + 0][bkg * 8] = v0;
      *(bf16x8*)&Bs[bnq * 4 + 1][bkg * 8] = v1;
      *(bf16x8*)&Bs[bnq * 4 + 2][bkg * 8] = v2;
      *(bf16x8*)&Bs[bnq * 4 + 3][bkg * 8] = v3;
    }
    __syncthreads();
    if (kt + 1 < nk) fetch(kt + 1);
#pragma unroll
    for (int ks = 0; ks < 2; ++ks) {
      bf16x8 af[4], bfr[4];
#pragma unroll
      for (int i = 0; i < 4; ++i) af[i] = *(const bf16x8*)&As[wm * 64 + i * 16 + (lane & 15)][ks * 32 + (lane >> 4) * 8];
#pragma unroll
      for (int j = 0; j < 4; ++j) bfr[j] = *(const bf16x8*)&Bs[wn * 64 + j * 16 + (lane & 15)][ks * 32 + (lane >> 4) * 8];
#pragma unroll
      for (int i = 0; i < 4; ++i)
#pragma unroll
        for (int j = 0; j < 4; ++j) acc[i][j] = __builtin_amdgcn_mfma_f32_16x16x32_bf16(bfr[j], af[i], acc[i][j], 0, 0, 0);
    }
    __syncthreads();
  }
#pragma unroll
  for (int i = 0; i < 4; ++i)
#pragma unroll
    for (int j = 0; j < 4; ++j) ep(m0 + wm * 64 + i * 16 + (lane & 15), n0 + wn * 64 + j * 16 + (lane >> 4) * 4, acc[i][j]);
}

static constexpr int GBN = 256;
template <class EP>
DEV void gemm_tile_bt(const bf16_t* __restrict__ Ap, int lda, const bf16_t* __restrict__ Bt, int K, int m0, int n0, const EP& ep, char* smem, const int tid) {
  bf16_t (*As)[48] = (bf16_t (*)[48])smem;
  bf16_t (*Bs)[48] = (bf16_t (*)[48])(smem + 128 * 48 * 2);
  const int lane = tid & 63, w = tid >> 6, wm = w >> 1, wn = w & 1;
  f32x4 acc[4][8];
#pragma unroll
  for (int i = 0; i < 4; ++i)
#pragma unroll
    for (int j = 0; j < 8; ++j) acc[i][j] = f32x4{0.f, 0.f, 0.f, 0.f};
  bf16x8 ra0[2], rb0[4];
  const int ari = tid >> 2;
  const int arow = (ari & ~3) | ((ari & 1) << 1) | ((ari >> 1) & 1), akc = (tid & 3) * 8;
  const int nk = K >> 5;
  const bf16_t* Ag = Ap + (size_t)(m0 + arow) * lda + akc;
  const bf16_t* Bg = Bt + (size_t)(n0 + arow) * K + akc;
#define BT_FETCH(kt, ra, rb)                                                                      \
  {                                                                                                \
    _Pragma("unroll") for (int i = 0; i < 2; ++i) ra[i] = *(const bf16x8*)(Ag + (size_t)(64 * i) * lda + (kt) * 32); \
    _Pragma("unroll") for (int i = 0; i < 4; ++i) rb[i] = *(const bf16x8*)(Bg + (size_t)(64 * i) * K + (kt) * 32);   \
  }
#define BT_STEP(kt, ra, rb)                                                                        \
  {                                                                                                \
    _Pragma("unroll") for (int i = 0; i < 2; ++i) *(bf16x8*)&As[arow + 64 * i][akc] = ra[i];      \
    _Pragma("unroll") for (int i = 0; i < 4; ++i) *(bf16x8*)&Bs[arow + 64 * i][akc] = rb[i];      \
    __syncthreads();                                                                               \
    if ((kt) + 1 < nk) BT_FETCH((kt) + 1, ra, rb)                                                  \
    {                                                                                              \
      bf16x8 af[4];                                                                                \
      _Pragma("unroll") for (int i = 0; i < 4; ++i) af[i] = *(const bf16x8*)&As[wm * 64 + i * 16 + (lane & 15)][(lane >> 4) * 8];  \
      _Pragma("unroll") for (int jh = 0; jh < 2; ++jh) {                                           \
        bf16x8 bfr[4];                                                                             \
        _Pragma("unroll") for (int j = 0; j < 4; ++j) bfr[j] = *(const bf16x8*)&Bs[wn * 128 + (jh * 4 + j) * 16 + (lane & 15)][(lane >> 4) * 8]; \
        _Pragma("unroll") for (int i = 0; i < 4; ++i)                                              \
          _Pragma("unroll") for (int j = 0; j < 4; ++j) acc[i][jh * 4 + j] = __builtin_amdgcn_mfma_f32_16x16x32_bf16(bfr[j], af[i], acc[i][jh * 4 + j], 0, 0, 0); \
        __builtin_amdgcn_sched_barrier(0);                                                         \
      }                                                                                            \
    }                                                                                              \
    __syncthreads();                                                                               \
  }
  BT_FETCH(0, ra0, rb0)
  for (int kt = 0; kt < nk; ++kt) {
    BT_STEP(kt, ra0, rb0)
  }
#undef BT_FETCH
#undef BT_STEP
#pragma unroll
  for (int i = 0; i < 4; ++i)
#pragma unroll
    for (int j = 0; j < 8; ++j) ep(m0 + wm * 64 + i * 16 + (lane & 15), n0 + wn * 128 + j * 16 + (lane >> 4) * 4, acc[i][j]);
}

DEV void convert_wt(const float* W, int K, int N, bf16_t* WT, int worker, int nworkers, char* smem, int tid) {
  const int nt_n = N >> 6;
  const int total = (K >> 6) * nt_n;
  for (int t0 = worker; t0 < total; t0 += 4 * nworkers) {
    const float* in[4] = {W, W, W, W};
    bf16_t* out[4] = {WT, WT, WT, WT};
    size_t rc[4], oc[4];
    int nvalid = 0;
#pragma unroll
    for (int q = 0; q < 4; ++q) {
      const int t = t0 + q * nworkers;
      const int tc = t < total ? t : t0;
      const int kt = tc / nt_n, nt = tc % nt_n;
      rc[q] = (size_t)(kt * 64) * N + nt * 64;
      oc[q] = (size_t)(nt * 64) * K + kt * 64;
      nvalid += (t < total) ? 1 : 0;
    }
    transpose_tiles4(in, rc, N, out, oc, K, nvalid, smem, tid);
  }
}

DEV void tile_map(int t, int lognt, int& mt, int& nt) {
  if (gridDim.x == 512) {
    const int r = t >> 9, b = t & 511;
    const int xcd = b & 7, slot = b >> 3;
    const int logpc = lognt - 3;
    const int pc = xcd & ((1 << logpc) - 1), pr = xcd >> logpc;
    mt = r * (64 >> logpc) + pr * 8 + (slot >> 3);
    nt = pc * 8 + (slot & 7);
  } else {
    nt = t & ((1 << lognt) - 1);
    mt = t >> lognt;
  }
}
static constexpr int MT = TTOK / 128;

DEV void phase_lru_in(const int wv, const Params& p, int j, char* smem) {
  const int tid = TID, bid = BID;
  EpXZ ep{p.BA, p.BB};
  const bf16_t* Bt = p.WB + ((size_t)DM * EI);
  for (int t = bid; t < MT * 32; t += gridDim.x) {
    int nt, mt; tile_map(t, 5, mt, nt);
    gemm_tile_bt(p.H, DM, Bt, DM, mt * 128, nt * GBN, ep, smem, tid);
  }
}
DEV void phase_out_proj(const int wv, const Params& p, const bf16_t* A, const bf16_t* Wt, float* Mout, char* smem) {
  const int tid = TID, bid = BID;
  EpF32 ep{Mout, DM};
  for (int t = bid; t < MT * 8; t += gridDim.x) {
    int nt, mt; tile_map(t, 3, mt, nt);
    gemm_tile_bt(A, EI, Wt, EI, mt * 128, nt * GBN, ep, smem, tid);
  }
}
DEV void phase_conv(const int wv, const Params& p, int j, char* smem) {
  const bf16_t* XB = p.BA;
  bf16_t* XC = p.BC;
  const float* cw = p.lru_conv_w + (size_t)j * 4 * EI;
  const float* cb = p.lru_conv_b + (size_t)j * EI;
  const int total = TTOK * 512;
  const int tid = TID, bid = BID;
  for (int idx = bid * 256 + tid; idx < total; idx += gridDim.x * 256) {
    int g = idx >> 9, e = (idx & 511) * 8;
    int t, L;
    if (g < TCTX) { t = g & 255; L = 256; } else { t = (g - TCTX) & 4095; L = 4096; }
    float acc[8];
    {
      float4 b0 = *(const float4*)(cb + e), b1 = *(const float4*)(cb + e + 4);
      acc[0] = b0.x; acc[1] = b0.y; acc[2] = b0.z; acc[3] = b0.w; acc[4] = b1.x; acc[5] = b1.y; acc[6] = b1.z; acc[7] = b1.w;
    }
#pragma unroll
    for (int tap = 0; tap < 4; ++tap) {
      int tt = t + tap - 2;
      if (tt >= 0 && tt < L) {
        bf16x8 xv = *(const bf16x8*)(XB + (size_t)(g + tap - 2) * EI + e);
        float4 w0 = *(const float4*)(cw + tap * EI + e), w1 = *(const float4*)(cw + tap * EI + e + 4);
        acc[0] += w0.x * bfs(xv[0]); acc[1] += w0.y * bfs(xv[1]); acc[2] += w0.z * bfs(xv[2]); acc[3] += w0.w * bfs(xv[3]);
        acc[4] += w1.x * bfs(xv[4]); acc[5] += w1.y * bfs(xv[5]); acc[6] += w1.z * bfs(xv[6]); acc[7] += w1.w * bfs(xv[7]);
      }
    }
    *(bf16x8*)(XC + (size_t)g * EI + e) = pack8bf(acc[0], acc[1], acc[2], acc[3], acc[4], acc[5], acc[6], acc[7]);
  }
  convert_wt(p.lru_w_out + (size_t)j * EI * DM, EI, DM, p.WB + ((size_t)DM * EI), bid, gridDim.x, smem, tid);
}

DEV void lru_item(const Params& p, int j, int item, char* smem, const int tid) {
  float (*sA)[64][64] = (float (*)[64][64])smem;
  float (*sU)[64][64] = (float (*)[64][64])(smem + 32768);
  const bf16_t* XC = p.BC;
  const bf16_t* ZB = p.BB;
  bf16_t* Y = p.BA;
  const int lane = tid & 63, w = tid >> 6;
  int s, n, sl;
  if (item < 256) { s = 32 + (item >> 6); n = (item & 63) >> 2; sl = item & 3; }
  else { int i2 = item - 256; s = i2 >> 6; n = (i2 & 63) >> 2; sl = i2 & 3; }
  const int L = s < 32 ? 256 : 4096;
  const size_t g0 = s < 32 ? (size_t)s * 256 : (size_t)TCTX + (size_t)(s - 32) * 4096;
  const int NT = L >> 6;
  const int e0 = n * 256 + sl * 64;
  const int sd = tid >> 6, sch = tid & 63;
  float hst = 0.f;
  if (tid < 128 && s >= 32) hst = p.state_lru[(size_t)(((s - 32) * 2 + j) * 2 + sd) * EI + e0 + sch];
  const int ch = w * 16 + (lane & 15);
  float gbr[2], gbi[2], sp[2];
#pragma unroll
  for (int d = 0; d < 2; ++d) {
    gbr[d] = p.lru_gate_b[(size_t)((j * 2 + d) * 2 + 0) * EI + e0 + ch];
    gbi[d] = p.lru_gate_b[(size_t)((j * 2 + d) * 2 + 1) * EI + e0 + ch];
    float lam = p.lru_lambda[(size_t)(j * 2 + d) * EI + e0 + ch];
    float xx = -lam;
    { float tt = __expf(xx); float ser = tt * (1.f + tt * (-0.5f + tt * (0.33333334f + tt * (-0.25f + tt * 0.2f)))); sp[d] = xx > 20.f ? xx : (tt < 0.05f ? ser : __logf(1.f + tt)); }
  }
  for (int it = 0; it < NT; ++it) {
    const bool first = it < (NT >> 1);
    bf16x8 partv[2][2], zv[2][2];
    {
      const size_t gt0 = g0 + (size_t)it * 64, gt1 = g0 + (size_t)(NT - 1 - it) * 64;
      bf16_t (*At)[64][264] = (bf16_t (*)[64][264])smem;
      bf16x8 areg[2][8];
#pragma unroll
      for (int i = 0; i < 8; ++i) {
        const int id = tid + 256 * i;
        const int row = id >> 5, c8 = (id & 31) * 8;
        areg[0][i] = *(const bf16x8*)(XC + (gt0 + row) * EI + n * 256 + c8);
        areg[1][i] = *(const bf16x8*)(XC + (gt1 + row) * EI + n * 256 + c8);
      }
      const bf16_t* Bw0r = p.WB + ((((size_t)0 * 2 + 0) * 16 + n) * 256 + (sl * 64 + ch)) * 256 + (lane >> 4) * 8;
      const bf16_t* Bw0i = p.WB + ((((size_t)0 * 2 + 1) * 16 + n) * 256 + (sl * 64 + ch)) * 256 + (lane >> 4) * 8;
      const bf16_t* Bw1r = p.WB + ((((size_t)1 * 2 + 0) * 16 + n) * 256 + (sl * 64 + ch)) * 256 + (lane >> 4) * 8;
      const bf16_t* Bw1i = p.WB + ((((size_t)1 * 2 + 1) * 16 + n) * 256 + (sl * 64 + ch)) * 256 + (lane >> 4) * 8;
      bf16x8 brA[4], biA[4], brB[4], biB[4];
#define LRU_LOADB(BR, BI, PR, PI, half) \
  _Pragma("unroll") for (int ks = 0; ks < 4; ++ks) { BR[ks] = *(const bf16x8*)(PR + ((half) * 4 + ks) * 32); BI[ks] = *(const bf16x8*)(PI + ((half) * 4 + ks) * 32); }
#define LRU_MMA(d, half, BR, BI)                                                                                  \
  _Pragma("unroll") for (int ks = 0; ks < 4; ++ks)                                                                \
    _Pragma("unroll") for (int mb = 0; mb < 4; ++mb) {                                                            \
      const bf16x8 af = *(const bf16x8*)&At[d][mb * 16 + (lane & 15)][((half) * 4 + ks) * 32 + (lane >> 4) * 8]; \
      ar[d][mb] = __builtin_amdgcn_mfma_f32_16x16x32_bf16(af, BR[ks], ar[d][mb], 0, 0, 0);                        \
      ai[d][mb] = __builtin_amdgcn_mfma_f32_16x16x32_bf16(af, BI[ks], ai[d][mb], 0, 0, 0);                        \
    }
      LRU_LOADB(brA, biA, Bw0r, Bw0i, 0)
      LRU_LOADB(brB, biB, Bw0r, Bw0i, 1)
      __builtin_amdgcn_sched_barrier(0);
#pragma unroll
      for (int i = 0; i < 8; ++i) {
        const int id = tid + 256 * i;
        const int row = id >> 5, c8 = (id & 31) * 8;
        *(bf16x8*)&At[0][row][c8] = areg[0][i];
        *(bf16x8*)&At[1][row][c8] = areg[1][i];
      }
      __syncthreads();
      f32x4 ar[2][4], ai[2][4];
#pragma unroll
      for (int d = 0; d < 2; ++d)
#pragma unroll
        for (int mb = 0; mb < 4; ++mb) { ar[d][mb] = f32x4{0.f, 0.f, 0.f, 0.f}; ai[d][mb] = f32x4{0.f, 0.f, 0.f, 0.f}; }
      LRU_MMA(0, 0, brA, biA)
      __builtin_amdgcn_sched_barrier(0);
      LRU_LOADB(brA, biA, Bw1r, Bw1i, 0)
      LRU_MMA(0, 1, brB, biB)
      __builtin_amdgcn_sched_barrier(0);
      LRU_LOADB(brB, biB, Bw1r, Bw1i, 1)
      LRU_MMA(1, 0, brA, biA)
      __builtin_amdgcn_sched_barrier(0);
      LRU_MMA(1, 1, brB, biB)
#undef LRU_LOADB
#undef LRU_MMA
      unsigned short xfr[2][4][4];
#pragma unroll
      for (int d = 0; d < 2; ++d)
#pragma unroll
        for (int mb = 0; mb < 4; ++mb)
#pragma unroll
          for (int r = 0; r < 4; ++r) xfr[d][mb][r] = At[d][mb * 16 + (lane >> 4) * 4 + r][sl * 64 + ch];
      if (!first) {
#pragma unroll
        for (int d = 0; d < 2; ++d) {
          const size_t gt = d == 0 ? gt0 : gt1;
#pragma unroll
          for (int i = 0; i < 2; ++i) {
            int idx = tid + 256 * i;
            int tok = idx >> 3, cc = idx & 7;
            size_t g = gt + tok;
            partv[d][i] = *(const bf16x8*)(Y + g * EI + e0 + cc * 8);
            zv[d][i] = *(const bf16x8*)(ZB + g * EI + e0 + cc * 8);
          }
        }
      }
      __syncthreads();
#pragma unroll
      for (int d = 0; d < 2; ++d)
#pragma unroll
        for (int mb = 0; mb < 4; ++mb)
#pragma unroll
          for (int r = 0; r < 4; ++r) {
            int tok = mb * 16 + (lane >> 4) * 4 + r;
            float rg = sigmoidf_(ar[d][mb][r] + gbr[d]);
            float ig = sigmoidf_(ai[d][mb][r] + gbi[d]);
            float la = -8.f * rg * sp[d];
            float a = __expf(la);
            float x2 = -2.f * la;
            float poly = x2 * (1.f + x2 * (-0.5f + x2 * (0.16666667f + x2 * (-0.041666668f + x2 * (0.0083333338f + x2 * (-0.0013888889f))))));
            float om = x2 < 0.4f ? poly : 1.f - __expf(-x2);
            float u = __builtin_amdgcn_sqrtf(fmaxf(om, 0.f)) * (ig * bf2f(xfr[d][mb][r]));
            sA[d][tok][ch] = a;
            sU[d][tok][ch] = u;
          }
    }
    __syncthreads();
    if (tid < 128) {
#pragma unroll 1
      for (int c0 = 0; c0 < 64; c0 += 16) {
        float av[16], uv[16];
#pragma unroll
        for (int t = 0; t < 16; ++t) {
          const int tok = sd == 0 ? c0 + t : 63 - (c0 + t);
          av[t] = sA[sd][tok][sch];
          uv[t] = sU[sd][tok][sch];
        }
#pragma unroll
        for (int t = 0; t < 16; ++t) { hst = av[t] * hst + uv[t]; uv[t] = hst; }
#pragma unroll
        for (int t = 0; t < 16; ++t) {
          const int tok = sd == 0 ? c0 + t : 63 - (c0 + t);
          sU[sd][tok][sch] = uv[t];
        }
      }
    }
    __syncthreads();
#pragma unroll
    for (int d = 0; d < 2; ++d) {
      const int tile = d == 0 ? it : NT - 1 - it;
#pragma unroll
      for (int i = 0; i < 2; ++i) {
        int idx = tid + 256 * i;
        int tok = idx >> 3, cc = idx & 7;
        size_t g = g0 + (size_t)tile * 64 + tok;
        float4 y0 = *(const float4*)&sU[d][tok][cc * 8], y1 = *(const float4*)&sU[d][tok][cc * 8 + 4];
        float y[8] = {y0.x, y0.y, y0.z, y0.w, y1.x, y1.y, y1.z, y1.w};
        bf16_t* yp = Y + g * EI + e0 + cc * 8;
        if (first) {
          *(bf16x8*)yp = pack8bf(y[0], y[1], y[2], y[3], y[4], y[5], y[6], y[7]);
        } else {
          bf16x8 part = partv[d][i], z = zv[d][i];
          *(bf16x8*)yp = pack8bf((y[0] + bfs(part[0])) * bfs(z[0]), (y[1] + bfs(part[1])) * bfs(z[1]), (y[2] + bfs(part[2])) * bfs(z[2]),
                                 (y[3] + bfs(part[3])) * bfs(z[3]), (y[4] + bfs(part[4])) * bfs(z[4]), (y[5] + bfs(part[5])) * bfs(z[5]),
                                 (y[6] + bfs(part[6])) * bfs(z[6]), (y[7] + bfs(part[7])) * bfs(z[7]));
        }
      }
    }
    __syncthreads();
  }
  if (tid < 128 && s < 32) p.out[OFF_LRU + (size_t)((s * 2 + j) * 2 + sd) * EI + e0 + sch] = hst;
}
DEV void phase_lru_scan(const int wv, const Params& p, int j, char* smem) {
  const int tid = TID;
  const int G = gridDim.x, b = BID;
  int item, step;
  if (G >= 320) { if (b < 256) { item = b; step = 1 << 20; } else { item = b; step = G - 256; } }
  else { item = b; step = G; }
  for (; item < 2304; item += step) lru_item(p, j, item, smem, tid);
}

DEV void phase_mix(const int wv, const Params& p, int j) {
  const int tid = TID, bid = BID;
  const float* mu = p.mu + (size_t)j * 5 * DM;
  const size_t HALF = (size_t)TTOK * DM;
  bf16_t* dst[5] = {p.BA, p.BB + HALF, p.BA + HALF, p.BB, p.BC};
  for (int idx = bid * 256 + tid; idx < TTOK * 256; idx += gridDim.x * 256) {
    const int row = idx >> 8, k = (idx & 255) * 8;
    int srow; bool valid;
    if (row < TCTX) {
      int t = row & 255;
      if (k < 1024) { srow = row - 1; valid = t > 0; } else { srow = row + 1; valid = t < 255; }
    } else {
      int t = (row - TCTX) & 4095;
      int q = k >> 9;
      if (q == 0) { srow = row - 1; valid = (t & 63) != 0; }
      else if (q == 1) { srow = row + 1; valid = (t & 63) != 63; }
      else if (q == 2) { srow = row - 64; valid = t >= 64; }
      else { srow = row + 64; valid = t < 4096 - 64; }
    }
    bf16x8 hv = *(const bf16x8*)(p.H + (size_t)row * DM + k);
    bf16x8 sv = *(const bf16x8*)(p.H + (size_t)(valid ? srow : row) * DM + k);
    float h[8], dx[8];
#pragma unroll
    for (int i = 0; i < 8; ++i) { h[i] = bfs(hv[i]); dx[i] = valid ? bfs(sv[i]) - h[i] : -h[i]; }
#pragma unroll
    for (int m = 0; m < 5; ++m) {
      float4 m0 = *(const float4*)(mu + m * DM + k), m1 = *(const float4*)(mu + m * DM + k + 4);
      *(bf16x8*)(dst[m] + (size_t)row * DM + k) =
          pack8bf(h[0] + dx[0] * m0.x, h[1] + dx[1] * m0.y, h[2] + dx[2] * m0.z, h[3] + dx[3] * m0.w,
                  h[4] + dx[4] * m1.x, h[5] + dx[5] * m1.y, h[6] + dx[6] * m1.z, h[7] + dx[7] * m1.w);
    }
  }
}
DEV void phase_rwkv_ga(const int wv, const Params& p, int j, char* smem) {
  const int tid = TID, bid = BID;
  const size_t HALF = (size_t)TTOK * DM;
  const int T0 = (j == 0) ? MT * 16 : 0;
  const int nsmall = (j == 0) ? 4 : 5;
  const int total = T0 + MT * nsmall;
  for (int t = bid; t < total; t += gridDim.x) {
    if (t < T0) {
      int nt, mt; tile_map(t, 4, mt, nt);
      EpBF16 ep{p.VF, EI};
      gemm_tile_bt(p.BB, DM, p.WB, DM, mt * 128, nt * GBN, ep, smem, tid);
    } else {
      int loc = t - T0;
      int job = loc / MT, mt = loc % MT;
      const bf16_t* Aj; const float* Bj; int ldbj = 128, nvj = 128, tanhj = 0; bf16_t* Cj;
      if (job < 2) { Aj = p.BB + HALF; Bj = p.w1 + (size_t)(j * 2 + job) * DM * 128; Cj = p.LORA1 + job * 128; tanhj = 1; }
      else if (job < 4) { Aj = p.BC; Bj = p.a1 + (size_t)(j * 2 + (job - 2)) * DM * 128; Cj = p.LORA1 + 256 + (job - 2) * 128; }
      else { Aj = p.BB; Bj = p.v1; ldbj = 96; nvj = 96; Cj = p.LORA1 + 512; }
      ALPlain alj{Aj, DM};
      EpLora ep{Cj, tanhj};
      gemm_tile<true>(alj, Bj, ldbj, DM, nvj, DM, mt * 128, 0, ep, smem, tid);
    }
  }
}
DEV void phase_rwkv_gb(const int wv, const Params& p, char* smem) {
  const int tid = TID, bid = BID;
  ALPlain all{p.LORA1 + 512, 640};
  EpVmix ep1{p.BC, p.v0};
  EpVmixV ep2{p.VF, p.BC};
  for (int t = bid; t < MT * 16; t += gridDim.x) {
    int nt, mt; tile_map(t, 4, mt, nt);
    gemm_tile<true>(all, p.v2, EI, 96, EI, 128, mt * 128, nt * GBN, ep1, smem, tid);
    gemm_tile<true>(all, p.v2, EI, 96, EI, 128, mt * 128, nt * GBN + 128, ep1, smem, tid);
    __syncthreads();
    gemm_tile_bt(p.BB, DM, p.WB, DM, mt * 128, nt * GBN, ep2, smem, tid);
  }
}
DEV void phase_rwkv_gc(const int wv, const Params& p, int j, char* smem) {
  const int tid = TID, bid = BID;
  const size_t HALF = (size_t)TTOK * DM;
  EpBF16 epr{p.BB, EI}, epk{p.BC, EI};
  for (int t = bid; t < MT * 32; t += gridDim.x) {
    int job = t / (MT * 16), loc = t % (MT * 16);
    int nt, mt; tile_map(loc, 4, mt, nt);
    if (job == 0) gemm_tile_bt(p.BA, DM, p.WB + ((size_t)DM * EI), DM, mt * 128, nt * GBN, epr, smem, tid);
    else gemm_tile_bt(p.BA + HALF, DM, p.WB + 2 * ((size_t)DM * EI), DM, mt * 128, nt * GBN, epk, smem, tid);
  }
}
DEV void phase_rwkv_gz(const int wv, const Params& p, int j, char* smem) {
  const int tid = TID, bid = BID;
  EpZ ep{p.BA};
  for (int t = bid; t < MT * 16; t += gridDim.x) {
    int nt, mt; tile_map(t, 4, mt, nt);
    gemm_tile_bt(p.H, DM, p.WB, DM, mt * 128, nt * GBN, ep, smem, tid);
  }
}

DEV void rwkv_item(const Params& p, int j, int item, char* smem, const int tid) {
  const int lane = tid & 63, w = tid >> 6;
  const int d = w & 1;
  const bool producer = w >= 2;
  float* rec = (float*)smem;
  float* yout = rec + 12288;
  float* bsl = yout + 2048;
  const bf16_t* R = p.BB;
  const bf16_t* Kb = p.BC;
  const bf16_t* V = p.VF;
  bf16_t* Y = p.BA;
  int s, hd;
  if (item < 256) { s = 32 + (item >> 6); hd = item & 63; } else { s = (item - 256) >> 6; hd = (item - 256) & 63; }
  const int L = s < 32 ? 256 : 4096;
  const size_t g0 = s < 32 ? (size_t)s * 256 : (size_t)TCTX + (size_t)(s - 32) * 4096;
  const int NT = L >> 3;
  const int el = hd * 64 + lane;
  if (s >= 32) __builtin_amdgcn_s_setprio(3);

  if (!producer) {
    float S[64];
    if (s >= 32) {
      const float* sp = p.state_rwkv + ((size_t)((((s - 32) * 2 + j) * 2 + d) * 64 + hd)) * 4096 + lane * 64;
#pragma unroll
      for (int k = 0; k < 64; k += 4) { float4 v = *(const float4*)(sp + k); S[k] = v.x; S[k + 1] = v.y; S[k + 2] = v.z; S[k + 3] = v.w; }
    } else {
#pragma unroll
      for (int k = 0; k < 64; ++k) S[k] = 0.f;
    }
    const int l4 = (lane & 3) * 4;
#define DPP_FMAC(acc, x, sv, J) asm("v_fmac_f32_dpp %0, %1, %2 quad_perm:[" #J "," #J "," #J "," #J "] row_mask:0xf bank_mask:0xf" : "+v"(acc) : "v"(x), "v"(sv))
#define DPP_MULS(sv, x, J) asm("v_mul_f32_dpp %0, %1, %0 quad_perm:[" #J "," #J "," #J "," #J "] row_mask:0xf bank_mask:0xf" : "+v"(sv) : "v"(x))
#define UPD_E(C, k, comp, J)            \
  DPP_FMAC(S[k], C[0].comp, sa, J);     \
  DPP_FMAC(S[k], C[1].comp, vq, J);
#define UPD_Q(C, m, J)                    \
  UPD_E(C, 16 * (m) + 4 * (J) + 0, x, J)  \
  UPD_E(C, 16 * (m) + 4 * (J) + 1, y, J)  \
  UPD_E(C, 16 * (m) + 4 * (J) + 2, z, J)  \
  UPD_E(C, 16 * (m) + 4 * (J) + 3, w, J)
#define UPD_M(C, m) UPD_Q(C, m, 0) UPD_Q(C, m, 1) UPD_Q(C, m, 2) UPD_Q(C, m, 3)
#define DOT_M(acc0, acc1, V, m)                                                               \
  _Pragma("unroll") for (int cc = 0; cc < 4; ++cc) {                                          \
    acc0 += fl2_t{S[16 * (m) + 4 * cc], S[16 * (m) + 4 * cc + 1]} * fl2_t{V[cc].x, V[cc].y};  \
    acc1 += fl2_t{S[16 * (m) + 4 * cc + 2], S[16 * (m) + 4 * cc + 3]} * fl2_t{V[cc].z, V[cc].w}; \
  }
#define MUL_M(V, m)                                                                            \
  _Pragma("unroll") for (int cc = 0; cc < 4; ++cc) {                                          \
    fl2_t t0 = fl2_t{S[16 * (m) + 4 * cc], S[16 * (m) + 4 * cc + 1]} * fl2_t{V[cc].x, V[cc].y};  \
    fl2_t t1 = fl2_t{S[16 * (m) + 4 * cc + 2], S[16 * (m) + 4 * cc + 3]} * fl2_t{V[cc].z, V[cc].w}; \
    S[16 * (m) + 4 * cc] = t0.x; S[16 * (m) + 4 * cc + 1] = t0.y; S[16 * (m) + 4 * cc + 2] = t1.x; S[16 * (m) + 4 * cc + 3] = t1.y; \
  }
#define LOAD_V(V, base, m) _Pragma("unroll") for (int cc = 0; cc < 4; ++cc) V[cc] = *(const float4*)((base) + 16 * (m) + 4 * cc);
#define LOAD_C(C, vt, m)                         \
  C[0] = *(const float4*)((vt) + 128 + 16 * (m)); \
  C[1] = *(const float4*)((vt) + 192 + 16 * (m));
    __syncthreads();
    for (int i = 0; i <= NT; ++i) {
      if (i < NT) {
        const int b = i & 1;
        const float* ub0 = rec + ((b * 2 + d) * 8) * 384;
        float4 A0[4], A1[4], R0[4], W0[4], W1[4], C0[2], C1[2];
        LOAD_V(A0, ub0 + 64, 0)
        LOAD_V(A1, ub0 + 64, 1)
#pragma unroll 1
        for (int q = 0; q < 8; ++q) {
          const float* ub = ub0 + q * 384;
          const float* vt = ub + l4;
          const float vq = ub[320 + lane];
          fl2_t acc0 = {0.f, 0.f}, acc1 = {0.f, 0.f};
          __builtin_amdgcn_sched_barrier(0);
          LOAD_V(R0, ub + 64, 2)
          DOT_M(acc0, acc1, A0, 0)
          __builtin_amdgcn_sched_barrier(0);
          LOAD_V(A0, ub + 64, 3)
          DOT_M(acc0, acc1, A1, 1)
          __builtin_amdgcn_sched_barrier(0);
          LOAD_C(C0, vt, 0)
          LOAD_V(W0, ub, 0)
          DOT_M(acc0, acc1, R0, 2)
          __builtin_amdgcn_sched_barrier(0);
          LOAD_C(C1, vt, 1)
          LOAD_V(W1, ub, 1)
          LOAD_V(R0, ub + 256, 0)
          DOT_M(acc0, acc1, A0, 3)
          const float sa = (acc0.x + acc0.y) + (acc1.x + acc1.y);
          fl2_t y0 = {0.f, 0.f}, y1 = {0.f, 0.f};
          __builtin_amdgcn_sched_barrier(0);
          MUL_M(W0, 0)
          UPD_M(C0, 0)
          LOAD_C(C0, vt, 2)
          LOAD_V(W0, ub, 2)
          LOAD_V(A1, ub + 256, 1)
          DOT_M(y0, y1, R0, 0)
          __builtin_amdgcn_sched_barrier(0);
          MUL_M(W1, 1)
          UPD_M(C1, 1)
          LOAD_C(C1, vt, 3)
          LOAD_V(W1, ub, 3)
          LOAD_V(R0, ub + 256, 2)
          DOT_M(y0, y1, A1, 1)
          __builtin_amdgcn_sched_barrier(0);
          MUL_M(W0, 2)
          UPD_M(C0, 2)
          LOAD_V(A1, ub + 256, 3)
          DOT_M(y0, y1, R0, 2)
          __builtin_amdgcn_sched_barrier(0);
          MUL_M(W1, 3)
          UPD_M(C1, 3)
          LOAD_V(A0, ub + 384 + 64, 0)
          DOT_M(y0, y1, A1, 3)
          __builtin_amdgcn_sched_barrier(0);
          LOAD_V(A1, ub + 384 + 64, 1)
          yout[((b * 2 + d) * 8 + q) * 64 + lane] = (y0.x + y0.y) + (y1.x + y1.y);
        }
      }
      __syncthreads();
    }
#undef MUL_M
#undef DOT_M
#undef LOAD_V
#undef DPP_FMAC
#undef DPP_MULS
#undef UPD_E
#undef UPD_Q
#undef UPD_M
#undef LOAD_C
    if (s < 32) {
      float* dst = p.out + OFF_RWKV + ((size_t)(((s * 2 + j) * 2 + d) * 64 + hd)) * 4096 + lane * 64;
#pragma unroll
      for (int k = 0; k < 64; k += 4) *(float4*)(dst + k) = float4{S[k], S[k + 1], S[k + 2], S[k + 3]};
    }
  } else {
    const int hi = lane >> 5;
    const int c16 = lane & 15;
    const int qb = ((lane >> 4) & 1) * 4;
    float w0c[2], a0c[2], kkc[2], kac[2], rkc[2];
#pragma unroll
    for (int nbi = 0; nbi < 2; ++nbi) {
      const int e = hd * 64 + (hi * 2 + nbi) * 16 + c16;
      w0c[nbi] = p.w0[(size_t)(j * 2 + d) * EI + e];
      a0c[nbi] = p.a0[(size_t)(j * 2 + d) * EI + e];
      kkc[nbi] = p.k_k[(size_t)j * EI + e];
      kac[nbi] = p.k_a[(size_t)j * EI + e];
      rkc[nbi] = p.r_k[(size_t)j * EI + e];
    }
    const float lnw = p.ln_w[(size_t)j * EI + el];
    const float lnb = p.ln_b[(size_t)j * EI + el];
    const bf16_t* W2 = p.W2T + ((size_t)(j * 2 + d) * EI + hd * 64 + c16) * 128 + (lane >> 4) * 8;
    const bf16_t* A2 = p.A2T + ((size_t)(j * 2 + d) * EI + hd * 64 + c16) * 128 + (lane >> 4) * 8;
    float* BSme = p.BS + (size_t)d * TTOK * 64;
    const float* BSot = p.BS + (size_t)(1 - d) * TTOK * 64;

    auto tile_g = [&](int i, int q) -> size_t {
      return d == 0 ? g0 + (size_t)i * 8 + q : g0 + (size_t)(L - 1 - i * 8 - q);
    };
    bf16x8 xw[4], xa[4];
    unsigned short rr_[2][4], kx_[2][4], vv_[2][4];
    unsigned short ypart[8];
    float bso[8];
    auto prefetch_tile = [&](const int in) {
      const int inc = in < NT ? in : NT - 1;
      const bf16_t* Ap = p.LORA1 + tile_g(inc, lane & 7) * 640 + (lane >> 4) * 8;
#pragma unroll
      for (int ks = 0; ks < 4; ++ks) {
        xw[ks] = *(const bf16x8*)(Ap + d * 128 + ks * 32);
        xa[ks] = *(const bf16x8*)(Ap + 256 + d * 128 + ks * 32);
      }
    };
    auto load_part = [&](const int ip) {
#pragma unroll
      for (int q = 0; q < 8; ++q) {
        const size_t g = tile_g(ip, q);
        ypart[q] = Y[g * EI + el];
        bso[q] = BSot[g * 64 + hd];
      }
    };
    auto prod_iter = [&](const int ip, const int in) {
      const bool do_post = ip >= 0, do_prod = in < NT;
      const bool first = ip < (NT >> 1);
      if (do_post && !first) load_part(ip);
      bf16x8 bwA[4], baA[4];
#define LOAD_B(BW, BA_, ks)                                                  \
  _Pragma("unroll") for (int nb = 0; nb < 4; ++nb) {                         \
    BW[nb] = *(const bf16x8*)(W2 + (size_t)nb * 16 * 128 + (ks) * 32);       \
    BA_[nb] = *(const bf16x8*)(A2 + (size_t)nb * 16 * 128 + (ks) * 32);      \
  }
#define MFMA_B(BW, BA_, ks)                                                  \
  _Pragma("unroll") for (int nb = 0; nb < 4; ++nb) {                         \
    aw[nb] = __builtin_amdgcn_mfma_f32_16x16x32_bf16(xw[ks], BW[nb], aw[nb], 0, 0, 0);  \
    aa[nb] = __builtin_amdgcn_mfma_f32_16x16x32_bf16(xa[ks], BA_[nb], aa[nb], 0, 0, 0); \
  }
      if (do_prod) { LOAD_B(bwA, baA, 0) }
      __builtin_amdgcn_sched_barrier(0);
      if (do_post) {
        const int b = ip & 1;
#pragma unroll
        for (int q = 0; q < 8; ++q) {
          const size_t g = tile_g(ip, q);
          const float y = yout[((b * 2 + d) * 8 + q) * 64 + lane];
          const float bsq = bsl[(b * 2 + d) * 8 + q];
          if (first) {
            Y[g * EI + el] = f2bf(y);
            if (lane == 0) BSme[g * 64 + hd] = bsq;
          } else {
            const float vq = rec[((b * 2 + d) * 8 + q) * 384 + 320 + lane];
            const float yt = y + bf2f(ypart[q]);
            const float mean = wave_sum_fast(yt) * (1.f / 64.f);
            const float dv = yt - mean;
            const float var = wave_sum_fast(dv * dv) * (1.f / 64.f);
            const float yn = dv * __builtin_amdgcn_rsqf(var + 64e-5f) * lnw + lnb;
            Y[g * EI + el] = f2bf(yn + (bsq + bso[q]) * vq);
          }
        }
      }
      __builtin_amdgcn_sched_barrier(0);
      if (do_prod) {
        const int b = in & 1;
        f32x4 aw[4], aa[4];
#pragma unroll
        for (int nb = 0; nb < 4; ++nb) { aw[nb] = f32x4{0.f, 0.f, 0.f, 0.f}; aa[nb] = f32x4{0.f, 0.f, 0.f, 0.f}; }
#pragma unroll
        for (int nbi = 0; nbi < 2; ++nbi)
#pragma unroll
          for (int r = 0; r < 4; ++r) {
            const size_t g = tile_g(in, qb + r);
            const int e = hd * 64 + (hi * 2 + nbi) * 16 + c16;
            rr_[nbi][r] = R[g * EI + e];
            kx_[nbi][r] = Kb[g * EI + e];
            vv_[nbi][r] = V[g * EI + e];
          }
        MFMA_B(bwA, baA, 0)
        __builtin_amdgcn_sched_barrier(0);
        LOAD_B(bwA, baA, 1)
        MFMA_B(bwA, baA, 1)
        __builtin_amdgcn_sched_barrier(0);
        LOAD_B(bwA, baA, 2)
        MFMA_B(bwA, baA, 2)
        __builtin_amdgcn_sched_barrier(0);
        LOAD_B(bwA, baA, 3)
        MFMA_B(bwA, baA, 3)
        float dec[2][4], asg[2][4], kk[2][4], kd[2][4], rr[2][4], vv[2][4], ss[4], bs[4];
#pragma unroll
        for (int r = 0; r < 4; ++r) { ss[r] = 0.f; bs[r] = 0.f; }
#pragma unroll
        for (int nbi = 0; nbi < 2; ++nbi)
#pragma unroll
          for (int r = 0; r < 4; ++r) {
            const float wacc = hi ? aw[2 + nbi][r] : aw[nbi][r];
            const float aacc = hi ? aa[2 + nbi][r] : aa[nbi][r];
            dec[nbi][r] = __expf(-0.6065306597126334f * sigmoidf_(wacc + w0c[nbi]));
            asg[nbi][r] = sigmoidf_(aacc + a0c[nbi]);
            rr[nbi][r] = bf2f(rr_[nbi][r]);
            const float kx = bf2f(kx_[nbi][r]);
            vv[nbi][r] = bf2f(vv_[nbi][r]);
            kk[nbi][r] = kx * kkc[nbi];
            ss[r] += kk[nbi][r] * kk[nbi][r];
            kd[nbi][r] = kx * (1.f + (asg[nbi][r] - 1.f) * kac[nbi]);
            bs[r] += rr[nbi][r] * kd[nbi][r] * rkc[nbi];
          }
        {
          const bool qhi = (lane >> 4) & 1;
#pragma unroll
          for (int r = 0; r < 4; ++r) {
            float a = row_sum16(ss[r]);
            float c = row_sum16(bs[r]);
            float a0 = rdlane(a, 0) + rdlane(a, 32), a1 = rdlane(a, 16) + rdlane(a, 48);
            float c0 = rdlane(c, 0) + rdlane(c, 32), c1 = rdlane(c, 16) + rdlane(c, 48);
            ss[r] = qhi ? a1 : a0;
            bs[r] = qhi ? c1 : c0;
          }
        }
#pragma unroll
        for (int r = 0; r < 4; ++r) {
          const float inv = __builtin_amdgcn_rcpf(fmaxf(__builtin_amdgcn_sqrtf(ss[r]), 1e-12f));
          float* vt = rec + ((b * 2 + d) * 8 + qb + r) * 384;
#pragma unroll
          for (int nbi = 0; nbi < 2; ++nbi) {
            const int ch = (hi * 2 + nbi) * 16 + c16;
            const float kn = kk[nbi][r] * inv;
            vt[ch] = dec[nbi][r];
            vt[64 + ch] = -kn;
            vt[128 + ch] = kn * asg[nbi][r];
            vt[192 + ch] = kd[nbi][r];
            vt[256 + ch] = rr[nbi][r];
            vt[320 + ch] = vv[nbi][r];
          }
          if ((lane & 47) == 0) bsl[(b * 2 + d) * 8 + qb + r] = bs[r];
        }
      }
#undef LOAD_B
#undef MFMA_B
      prefetch_tile(in + 1);
    };
    prefetch_tile(0);
    prod_iter(-1, 0);
    __syncthreads();
    for (int i = 0; i <= NT; ++i) {
      prod_iter(i - 1, i + 1);
      __syncthreads();
    }
  }
  __builtin_amdgcn_s_setprio(0);
  __syncthreads();
}
DEV void phase_rwkv_scan(const int wv, const Params& p, int j, char* smem) {
  const int tid = TID;
  const int G = gridDim.x, b = BID;
  int item, step;
  if (G >= 320) { if (b < 256) { item = b; step = 1 << 20; } else { item = b; step = G - 256; } }
  else { item = b; step = G; }
  for (; item < 2304; item += step) rwkv_item(p, j, item, smem, tid);
  if (G >= 320) {
    if (b >= 256) {
      convert_wt(p.w_g + (size_t)j * DM * EI, DM, EI, p.WB, b - 256, G - 256, smem, tid);
      convert_wt(p.w_o + (size_t)j * EI * DM, EI, DM, p.WB + ((size_t)DM * EI), b - 256, G - 256, smem, tid);
    }
  } else {
    convert_wt(p.w_g + (size_t)j * DM * EI, DM, EI, p.WB, b, G, smem, tid);
    convert_wt(p.w_o + (size_t)j * EI * DM, EI, DM, p.WB + ((size_t)DM * EI), b, G, smem, tid);
  }
}

DEV void fast_barrier(unsigned* bar, const unsigned k) {
  asm volatile("s_waitcnt vmcnt(0)" ::: "memory");
  __syncthreads();
  if (threadIdx.x == 0) {
    __builtin_amdgcn_fence(__ATOMIC_RELEASE, "agent");
    asm volatile("s_waitcnt vmcnt(0)" ::: "memory");
    const unsigned G = gridDim.x;
    const unsigned g = blockIdx.x & 15u;
    const unsigned ng = (G - g + 15u) >> 4;
    const unsigned ngroups = G < 16u ? G : 16u;
    unsigned* grp_cnt = bar + 64 * g;
    unsigned* grp_gen = bar + 64 * (16 + g);
    unsigned* top_cnt = bar + 64 * 32;
    const unsigned old = __hip_atomic_fetch_add(grp_cnt, 1u, __ATOMIC_RELAXED, __HIP_MEMORY_SCOPE_AGENT);
    if (old + 1u == k * ng) {
      const unsigned oldt = __hip_atomic_fetch_add(top_cnt, 1u, __ATOMIC_RELAXED, __HIP_MEMORY_SCOPE_AGENT);
      if (oldt + 1u == k * ngroups) {
        for (unsigned gg = 0; gg < ngroups; ++gg) __hip_atomic_store(bar + 64 * (16 + gg), k, __ATOMIC_RELAXED, __HIP_MEMORY_SCOPE_AGENT);
      }
    }
    unsigned sp = 0;
    while (__hip_atomic_load(grp_gen, __ATOMIC_RELAXED, __HIP_MEMORY_SCOPE_AGENT) < k) {
      __builtin_amdgcn_s_sleep(1);
      if (++sp > (1u << 24)) break;
    }
    __builtin_amdgcn_fence(__ATOMIC_ACQUIRE, "agent");
    asm volatile("s_waitcnt vmcnt(0)" ::: "memory");
  }
  __syncthreads();
}

__global__ void __launch_bounds__(256, 2) mega_kernel(Params p) {
  __shared__ __attribute__((aligned(16))) char smem[69632];
  cg::grid_group grid = cg::this_grid();
  unsigned nbar = 0;
  const int wv = __builtin_amdgcn_readfirstlane((int)(threadIdx.x >> 6));
  phase_prep(wv, p, smem);
  grid.sync();
#pragma unroll 1
  for (int layer = 0; layer < 4; ++layer) {
    phase_row(wv, p, layer, smem);
    fast_barrier(p.BAR, ++nbar);
    const int j = layer >> 1;
    if ((layer & 1) == 0) {
      phase_lru_in(wv, p, j, smem);
      fast_barrier(p.BAR, ++nbar);
      phase_conv(wv, p, j, smem);
      fast_barrier(p.BAR, ++nbar);
      phase_lru_scan(wv, p, j, smem);
      fast_barrier(p.BAR, ++nbar);
      phase_out_proj(wv, p, p.BA, p.WB + ((size_t)DM * EI), (float*)p.BC, smem);
      fast_barrier(p.BAR, ++nbar);
    } else {
      phase_mix(wv, p, j);
      fast_barrier(p.BAR, ++nbar);
      phase_rwkv_ga(wv, p, j, smem);
      fast_barrier(p.BAR, ++nbar);
      if (j == 1) { phase_rwkv_gb(wv, p, smem); fast_barrier(p.BAR, ++nbar); }
      phase_rwkv_gc(wv, p, j, smem);
      fast_barrier(p.BAR, ++nbar);
      phase_rwkv_scan(wv, p, j, smem);
      fast_barrier(p.BAR, ++nbar);
      phase_rwkv_gz(wv, p, j, smem);
      fast_barrier(p.BAR, ++nbar);
      phase_out_proj(wv, p, p.BA, p.WB + ((size_t)DM * EI), (float*)p.BB, smem);
      fast_barrier(p.BAR, ++nbar);
    }
  }
  phase_row(wv, p, 4, smem);
}

extern "C" void kernel_launch(void* const* d_in, const int* in_sizes, int n_in, void* d_out, int out_size, void* d_ws, size_t ws_size,
                              hipStream_t stream) {
  static int grid_blocks = 0;
  if (!grid_blocks) {
    int dev = 0, cus = 0, per_cu = 0;
    hipGetDevice(&dev);
    hipDeviceGetAttribute(&cus, hipDeviceAttributeMultiprocessorCount, dev);
    hipOccupancyMaxActiveBlocksPerMultiprocessor(&per_cu, (const void*)mega_kernel, 256, 0);
    if (per_cu > 2) per_cu = 2;
    if (per_cu < 1) per_cu = 1;
    grid_blocks = cus * per_cu;
  }
  Params p{};
  const float* const* in = (const float* const*)d_in;
  p.x_prompt = in[0]; p.x_sample = in[1]; p.state_lru = in[2]; p.state_rwkv = in[3]; p.c = in[4]; p.c_ctx = in[5];
  p.ada_w = in[6]; p.ada_b = in[7]; p.norm_pre = in[8]; p.norm_post = in[9];
  p.lru_w_in = in[10]; p.lru_conv_w = in[11]; p.lru_conv_b = in[12]; p.lru_gate_w = in[13]; p.lru_gate_b = in[14];
  p.lru_lambda = in[15]; p.lru_w_out = in[16];
  p.mu = in[17]; p.w_r = in[18]; p.w_k = in[19]; p.w_v = in[20]; p.w_g = in[21]; p.w_o = in[22];
  p.w0 = in[23]; p.w1 = in[24]; p.w2 = in[25]; p.a0 = in[26]; p.a1 = in[27]; p.a2 = in[28];
  p.k_k = in[29]; p.k_a = in[30]; p.r_k = in[31]; p.ln_w = in[32]; p.ln_b = in[33]; p.v0 = in[34]; p.v1 = in[35]; p.v2 = in[36];
  p.out = (float*)d_out;
  char* ws = (char*)d_ws;
  size_t off = 0;
  auto take = [&](size_t bytes) { char* r = ws + off; off += (bytes + 255) & ~(size_t)255; return r; };
  p.MOD = (float*)take(4 * 5 * 6144 * 4);
  p.W2T = (bf16_t*)take((size_t)4 * 4096 * 128 * 2);
  p.A2T = (bf16_t*)take((size_t)4 * 4096 * 128 * 2);
  p.H = (bf16_t*)take((size_t)TTOK * DM * 2);
  p.BA = (bf16_t*)take((size_t)TTOK * EI * 2);
  p.BB = (bf16_t*)take((size_t)TTOK * EI * 2);
  p.BC = (bf16_t*)take((size_t)TTOK * EI * 2);
  p.VF = (bf16_t*)take((size_t)TTOK * EI * 2);
  p.LORA1 = (bf16_t*)take((size_t)TTOK * 640 * 2);
  p.BS = (float*)take((size_t)2 * TTOK * 64 * 4);
  p.WB = (bf16_t*)take((size_t)3 * DM * EI * 2);
  p.BAR = (unsigned*)take(16384);
  if (off > ws_size) { fprintf(stderr, "workspace too small: need %zu have %zu\n", off, ws_size); return; }
  hipMemsetAsync(p.BAR, 0, 16384, stream);
  void* args[] = {&p};
  hipError_t e = hipLaunchCooperativeKernel((const void*)mega_kernel, dim3(grid_blocks), dim3(256), args, 0, stream);
  if (e != hipSuccess) fprintf(stderr, "cooperative launch failed: %s (grid %d)\n", hipGetErrorString(e), grid_blocks);
}
```

```cpp
#include <hip/hip_runtime.h>
#include <hip/hip_cooperative_groups.h>
#include <stdint.h>
#include <stdio.h>
namespace cg = cooperative_groups;

#define DEV __device__ __forceinline__

typedef unsigned short bf16_t;
using bf16x8 = __attribute__((ext_vector_type(8))) short;
using f32x4 = __attribute__((ext_vector_type(4))) float;

static constexpr int DM = 2048;
static constexpr int EI = 4096;
static constexpr int TCTX = 8192;
static constexpr int TTOK = 24576;
static constexpr size_t OFF_LRU = 50331648ull;
static constexpr size_t OFF_RWKV = 50855936ull;

struct Params {
  const float *x_prompt, *x_sample, *state_lru, *state_rwkv, *c, *c_ctx, *ada_w, *ada_b, *norm_pre, *norm_post;
  const float *lru_w_in, *lru_conv_w, *lru_conv_b, *lru_gate_w, *lru_gate_b, *lru_lambda, *lru_w_out;
  const float *mu, *w_r, *w_k, *w_v, *w_g, *w_o, *w0, *w1, *w2, *a0, *a1, *a2, *k_k, *k_a, *r_k, *ln_w, *ln_b, *v0, *v1, *v2;
  float* out;
  float* MOD;
  bf16_t* WB;
  bf16_t* W2T;
  bf16_t* A2T;
  bf16_t* H;
  bf16_t* BA;
  bf16_t* BB;
  bf16_t* BC;
  bf16_t* VF;
  bf16_t* LORA1;
  float* BS;
  unsigned* BAR;
};

DEV bf16_t f2bf(float f) {
  uint32_t u = __float_as_uint(f);
  u += 0x7fffu + ((u >> 16) & 1u);
  return (bf16_t)(u >> 16);
}
DEV float bf2f(bf16_t h) { return __uint_as_float(((uint32_t)h) << 16); }
DEV float bfs(short h) { return __uint_as_float(((uint32_t)(unsigned short)h) << 16); }
DEV float rcpf_(float x) { return __builtin_amdgcn_rcpf(x); }
DEV float sigmoidf_(float x) { return rcpf_(1.f + __expf(-x)); }
DEV float siluf_(float x) { return x * rcpf_(1.f + __expf(-x)); }
DEV float wave_sum(float v) {
#pragma unroll
  for (int o = 32; o > 0; o >>= 1) v += __shfl_xor(v, o, 64);
  return v;
}
typedef __bf16 bf2_t __attribute__((ext_vector_type(2)));
typedef float fl2_t __attribute__((ext_vector_type(2)));
DEV uint32_t pack2bf(float a, float b) {
  fl2_t v = {a, b};
  bf2_t r = __builtin_convertvector(v, bf2_t);
  return *(uint32_t*)&r;
}
DEV bf16x8 pack8bf(float a0, float a1, float a2, float a3, float a4, float a5, float a6, float a7) {
  union { uint32_t u[4]; bf16x8 v; } x;
  x.u[0] = pack2bf(a0, a1); x.u[1] = pack2bf(a2, a3); x.u[2] = pack2bf(a4, a5); x.u[3] = pack2bf(a6, a7);
  return x.v;
}
DEV int opq(int v) { asm volatile("" : "+v"(v)); return v; }
DEV int opqs(int v) { asm volatile("" : "+s"(v)); return v; }
DEV int lane_id_() { return (int)__builtin_amdgcn_mbcnt_hi(~0u, __builtin_amdgcn_mbcnt_lo(~0u, 0u)); }
#define TID opq(wv * 64 + lane_id_())
#define BID opqs((int)blockIdx.x)
template <int CTRL>
DEV float dpp_f(float x) {
  int xi = __builtin_bit_cast(int, x);
  return __builtin_bit_cast(float, __builtin_amdgcn_update_dpp(xi, xi, CTRL, 0xf, 0xf, true));
}
DEV float row_sum16(float x) {
  x += dpp_f<0xB1>(x);
  x += dpp_f<0x4E>(x);
  x += dpp_f<0x124>(x);
  x += dpp_f<0x128>(x);
  return x;
}
DEV float rdlane(float x, int l) { return __builtin_bit_cast(float, __builtin_amdgcn_readlane(__builtin_bit_cast(int, x), l)); }
DEV float wave_sum_fast(float x) {
  x = row_sum16(x);
  return (rdlane(x, 0) + rdlane(x, 16)) + (rdlane(x, 32) + rdlane(x, 48));
}
DEV void store4bf(bf16_t* p, f32x4 v) {
  uint2 u;
  u.x = pack2bf(v[0], v[1]);
  u.y = pack2bf(v[2], v[3]);
  *(uint2*)p = u;
}
DEV f32x4 load4bf(const bf16_t* p) {
  uint2 u = *(const uint2*)p;
  f32x4 v;
  v[0] = __uint_as_float(u.x << 16);
  v[1] = __uint_as_float(u.x & 0xffff0000u);
  v[2] = __uint_as_float(u.y << 16);
  v[3] = __uint_as_float(u.y & 0xffff0000u);
  return v;
}

DEV void transpose_tile(const float* __restrict__ in, int ldin, bf16_t* __restrict__ out, int ldout, int r0, int c0, char* smem, int tid) {
  float (*t)[65] = (float (*)[65])smem;
  float4 v[4];
#pragma unroll
  for (int i = 0; i < 4; ++i) {
    int idx = tid + 256 * i;
    int r = idx >> 4, c4 = (idx & 15) * 4;
    v[i] = *(const float4*)(in + (size_t)(r0 + r) * ldin + c0 + c4);
  }
#pragma unroll
  for (int i = 0; i < 4; ++i) {
    int idx = tid + 256 * i;
    int r = idx >> 4, c4 = (idx & 15) * 4;
    t[r][c4] = v[i].x; t[r][c4 + 1] = v[i].y; t[r][c4 + 2] = v[i].z; t[r][c4 + 3] = v[i].w;
  }
  __syncthreads();
  uint32_t o[8];
#pragma unroll
  for (int i = 0; i < 8; ++i) {
    int idx = tid + 256 * i;
    int cc = idx >> 5, rp = idx & 31;
    o[i] = pack2bf(t[2 * rp][cc], t[2 * rp + 1][cc]);
  }
#pragma unroll
  for (int i = 0; i < 8; ++i) {
    int idx = tid + 256 * i;
    int cc = idx >> 5, rp = idx & 31;
    *(uint32_t*)(out + (size_t)(c0 + cc) * ldout + r0 + 2 * rp) = o[i];
  }
  __syncthreads();
}

DEV void transpose_tiles4(const float* const (&in)[4], const size_t (&rc)[4], int ldin, bf16_t* const (&out)[4], const size_t (&oc)[4], int ldout,
                          int nvalid, char* smem, int tid) {
  float (*t)[64][65] = (float (*)[64][65])smem;
  float4 v[4][4];
#pragma unroll
  for (int q = 0; q < 4; ++q)
    if (q < nvalid) {
#pragma unroll
      for (int i = 0; i < 4; ++i) {
        int idx = tid + 256 * i;
        int r = idx >> 4, c4 = (idx & 15) * 4;
        v[q][i] = *(const float4*)(in[q] + rc[q] + (size_t)r * ldin + c4);
      }
    }
#pragma unroll
  for (int q = 0; q < 4; ++q)
    if (q < nvalid) {
#pragma unroll
      for (int i = 0; i < 4; ++i) {
        int idx = tid + 256 * i;
        int r = idx >> 4, c4 = (idx & 15) * 4;
        t[q][r][c4] = v[q][i].x; t[q][r][c4 + 1] = v[q][i].y; t[q][r][c4 + 2] = v[q][i].z; t[q][r][c4 + 3] = v[q][i].w;
      }
    }
  __syncthreads();
#pragma unroll
  for (int q = 0; q < 4; ++q)
    if (q < nvalid) {
#pragma unroll
      for (int i = 0; i < 8; ++i) {
        int idx = tid + 256 * i;
        int cc = idx >> 5, rp = idx & 31;
        *(uint32_t*)(out[q] + oc[q] + (size_t)cc * ldout + 2 * rp) = pack2bf(t[q][2 * rp][cc], t[q][2 * rp + 1][cc]);
      }
    }
  __syncthreads();
}

DEV void convert_wt(const float* W, int K, int N, bf16_t* WT, int worker, int nworkers, char* smem, int tid);
DEV void phase_prep(const int wv, const Params& p, char* smem) {
  float* sc = (float*)smem;
  float* red = sc + 5 * 2048;
  const int tid = TID, bid = BID;
  for (int i = tid; i < 5 * 2048; i += 256) {
    int c = i >> 11, k = i & 2047;
    float v = (c == 0) ? p.c_ctx[k] : p.c[(c - 1) * 2048 + k];
    sc[i] = siluf_(v);
  }
  __syncthreads();
  int cq = tid & 7, kl = tid >> 3;
  for (int item = bid; item < 768; item += gridDim.x) {
    int l = item / 192, cgp = item % 192;
    int c0 = cgp * 32;
    const float* W = p.ada_w + (size_t)l * 2048 * 6144 + c0 + cq * 4;
    float acc[5][4];
#pragma unroll
    for (int c = 0; c < 5; ++c)
#pragma unroll
      for (int q = 0; q < 4; ++q) acc[c][q] = 0.f;
#pragma unroll 4
    for (int k = kl; k < 2048; k += 32) {
      float4 w4 = *(const float4*)(W + (size_t)k * 6144);
#pragma unroll
      for (int c = 0; c < 5; ++c) {
        float s = sc[c * 2048 + k];
        acc[c][0] += s * w4.x; acc[c][1] += s * w4.y; acc[c][2] += s * w4.z; acc[c][3] += s * w4.w;
      }
    }
    float* r = red + (kl * 8 + cq) * 20;
#pragma unroll
    for (int c = 0; c < 5; ++c)
#pragma unroll
      for (int q = 0; q < 4; ++q) r[c * 4 + q] = acc[c][q];
    __syncthreads();
    if (tid < 160) {
      int c = tid >> 5, col = tid & 31;
      float s = 0.f;
      for (int kk = 0; kk < 32; ++kk) s += red[(kk * 8 + (col >> 2)) * 20 + c * 4 + (col & 3)];
      p.MOD[(size_t)(l * 5 + c) * 6144 + c0 + col] = s + p.ada_b[l * 6144 + c0 + col];
    }
    __syncthreads();
  }
  for (int item = bid; item < 1024; item += gridDim.x) {
    int which = item >> 9;
    int rem = item & 511;
    int mat = rem >> 7, tl = rem & 127;
    const float* src = (which == 0 ? p.w2 : p.a2) + (size_t)mat * 128 * 4096;
    bf16_t* dst = (which == 0 ? p.W2T : p.A2T) + (size_t)mat * 4096 * 128;
    transpose_tile(src, 4096, dst, 128, (tl & 1) * 64, (tl >> 1) * 64, smem, tid);
  }
}

DEV void phase_row(const int wv, const Params& p, int layer, char* smem) {
  const int tid = TID, bid = BID;
  int lane = tid & 63, w = tid >> 6;
  for (int g = bid * 4 + w; g < TTOK; g += gridDim.x * 4) {
    int c = g < TCTX ? 0 : 1 + ((g - TCTX) >> 12);
    const float* xin;
    if (layer <= 1) xin = g < TCTX ? p.x_prompt + (size_t)g * DM : p.x_sample + (size_t)(g - TCTX) * DM;
    else xin = p.out + (size_t)g * DM;
    float4 x[8];
#pragma unroll
    for (int q = 0; q < 8; ++q) x[q] = ((const float4*)xin)[q * 64 + lane];
    if (layer > 0) {
      const float* M = (const float*)(((layer - 1) & 1) == 0 ? p.BC : p.BB) + (size_t)g * DM;
      float4 m[8];
      float ss = 0.f;
#pragma unroll
      for (int q = 0; q < 8; ++q) {
        m[q] = ((const float4*)M)[q * 64 + lane];
        ss += m[q].x * m[q].x + m[q].y * m[q].y + m[q].z * m[q].z + m[q].w * m[q].w;
      }
      ss = wave_sum_fast(ss);
      float rs = __builtin_amdgcn_rsqf(ss * (1.f / 2048.f) + 1e-6f);
      const float4* gate = (const float4*)(p.MOD + (size_t)((layer - 1) * 5 + c) * 6144 + 4096);
      const float4* np = (const float4*)(p.norm_post + (layer - 1) * DM);
#pragma unroll
      for (int q = 0; q < 8; ++q) {
        float4 gt = gate[q * 64 + lane], nn = np[q * 64 + lane];
        x[q].x += gt.x * (m[q].x * rs * nn.x);
        x[q].y += gt.y * (m[q].y * rs * nn.y);
        x[q].z += gt.z * (m[q].z * rs * nn.z);
        x[q].w += gt.w * (m[q].w * rs * nn.w);
        ((float4*)(p.out + (size_t)g * DM))[q * 64 + lane] = x[q];
      }
    }
    if (layer < 4) {
      float ss = 0.f;
#pragma unroll
      for (int q = 0; q < 8; ++q) ss += x[q].x * x[q].x + x[q].y * x[q].y + x[q].z * x[q].z + x[q].w * x[q].w;
      ss = wave_sum_fast(ss);
      float rs = __builtin_amdgcn_rsqf(ss * (1.f / 2048.f) + 1e-6f);
      const float4* sh = (const float4*)(p.MOD + (size_t)(layer * 5 + c) * 6144);
      const float4* scl = (const float4*)(p.MOD + (size_t)(layer * 5 + c) * 6144 + 2048);
      const float4* np = (const float4*)(p.norm_pre + layer * DM);
#pragma unroll
      for (int q = 0; q < 8; ++q) {
        float4 s1 = sh[q * 64 + lane], s2 = scl[q * 64 + lane], nn = np[q * 64 + lane];
        f32x4 h;
        h[0] = x[q].x * rs * nn.x * (1.f + s2.x) + s1.x;
        h[1] = x[q].y * rs * nn.y * (1.f + s2.y) + s1.y;
        h[2] = x[q].z * rs * nn.z * (1.f + s2.z) + s1.z;
        h[3] = x[q].w * rs * nn.w * (1.f + s2.w) + s1.w;
        store4bf(p.H + (size_t)g * DM + (q * 64 + lane) * 4, h);
      }
    }
  }
  if (layer < 4) {
    const int j = layer >> 1;
    const int G = gridDim.x;
    if ((layer & 1) == 0) {
      for (int it0 = bid; it0 < 1024; it0 += 4 * G) {
        const float* in[4]; bf16_t* out[4]; size_t rc[4], oc[4];
        int nvalid = 0;
#pragma unroll
        for (int q = 0; q < 4; ++q) {
          const int item = it0 + q * G;
          const int ic = item < 1024 ? item : it0;
          const int mat = ic >> 4, tl = ic & 15;
          in[q] = p.lru_gate_w + (size_t)(j * 64 + mat) * 65536;
          out[q] = p.WB + (size_t)mat * 65536;
          rc[q] = (size_t)((tl >> 2) * 64) * 256 + (tl & 3) * 64;
          oc[q] = (size_t)((tl & 3) * 64) * 256 + (tl >> 2) * 64;
          nvalid += (item < 1024) ? 1 : 0;
        }
        transpose_tiles4(in, rc, 256, out, oc, 256, nvalid, smem, tid);
      }
      convert_wt(p.lru_w_in + (size_t)j * DM * 8192, DM, 8192, p.WB + ((size_t)DM * EI), bid, G, smem, tid);
    } else {
      convert_wt(p.w_v + (size_t)j * DM * EI, DM, EI, p.WB, bid, G, smem, tid);
      convert_wt(p.w_r + (size_t)j * DM * EI, DM, EI, p.WB + ((size_t)DM * EI), bid, G, smem, tid);
      convert_wt(p.w_k + (size_t)j * DM * EI, DM, EI, p.WB + 2 * ((size_t)DM * EI), bid, G, smem, tid);
    }
  }
}

struct ALPlain {
  const bf16_t* p;
  int ld;
  struct Raw { bf16x8 v; };
  DEV void prep(int k) {}
  DEV void fetch(int row, int k, Raw& r) const { r.v = *(const bf16x8*)(p + (size_t)row * ld + k); }
  DEV bf16x8 finish(const Raw& r) const { return r.v; }
};
struct EpBF16 {
  bf16_t* C; int ldc;
  DEV void operator()(int m, int n, f32x4 v) const { store4bf(C + (size_t)m * ldc + n, v); }
};
struct EpXZ {
  bf16_t* X; bf16_t* Z;
  DEV void operator()(int m, int n, f32x4 v) const {
    if (n < EI) store4bf(X + (size_t)m * EI + n, v);
    else {
      f32x4 s;
#pragma unroll
      for (int i = 0; i < 4; ++i) s[i] = siluf_(v[i]);
      store4bf(Z + (size_t)m * EI + (n - EI), s);
    }
  }
};
struct EpF32 {
  float* C; int ldc;
  DEV void operator()(int m, int n, f32x4 v) const { *(f32x4*)(C + (size_t)m * ldc + n) = v; }
};
struct EpLora {
  bf16_t* C; int do_tanh;
  DEV void operator()(int m, int n, f32x4 v) const {
    if (do_tanh) {
#pragma unroll
      for (int i = 0; i < 4; ++i) { float xc = fminf(fmaxf(v[i], -15.f), 15.f); v[i] = 1.f - 2.f * rcpf_(1.f + __expf(2.f * xc)); }
    }
    store4bf(C + (size_t)m * 640 + n, v);
  }
};
struct EpVmix {
  bf16_t* C; const float* v0;
  DEV void operator()(int m, int n, f32x4 v) const {
    f32x4 b = *(const f32x4*)(v0 + n);
#pragma unroll
    for (int i = 0; i < 4; ++i) v[i] = sigmoidf_(v[i] + b[i]);
    store4bf(C + (size_t)m * EI + n, v);
  }
};
struct EpVmixV {
  bf16_t* VFp; const bf16_t* MIX;
  DEV void operator()(int m, int n, f32x4 v) const {
    f32x4 vf = load4bf(VFp + (size_t)m * EI + n);
    f32x4 mx = load4bf(MIX + (size_t)m * EI + n);
#pragma unroll
    for (int i = 0; i < 4; ++i) v[i] = v[i] + (vf[i] - v[i]) * mx[i];
    store4bf(VFp + (size_t)m * EI + n, v);
  }
};
struct EpZ {
  bf16_t* Y;
  DEV void operator()(int m, int n, f32x4 v) const {
    f32x4 y = load4bf(Y + (size_t)m * EI + n);
#pragma unroll
    for (int i = 0; i < 4; ++i) y[i] = y[i] * siluf_(v[i]);
    store4bf(Y + (size_t)m * EI + n, y);
  }
};

template <bool CHK, class AL, class EP>
DEV void gemm_tile(AL al, const float* __restrict__ Bp, int ldb, int Kv, int Nv, int K, int m0, int n0, const EP& ep, char* smem, const int tid) {
  bf16_t (*As)[80] = (bf16_t (*)[80])smem;
  bf16_t (*Bs)[80] = (bf16_t (*)[80])(smem + 128 * 80 * 2);
  const int lane = tid & 63, w = tid >> 6, wm = w >> 1, wn = w & 1;
  f32x4 acc[4][4];
#pragma unroll
  for (int i = 0; i < 4; ++i)
#pragma unroll
    for (int j = 0; j < 4; ++j) acc[i][j] = f32x4{0.f, 0.f, 0.f, 0.f};
  typename AL::Raw ra[4];
  float4 rb[8];
  const int arow = tid >> 3, akc = (tid & 7) * 8;
  const int bkg = tid >> 5, bnq = tid & 31;
  const int nk = K >> 6;
  const int bn = n0 + bnq * 4;

  const bool nok = bn < Nv;
  const int bnc = nok ? bn : 0;
  auto fetch = [&](int kt) {
#pragma unroll
    for (int i = 0; i < 4; ++i) al.fetch(m0 + arow + 32 * i, kt * 64 + akc, ra[i]);
    const int k0 = kt * 64 + bkg * 8;
    const bool ok = CHK ? (nok && (k0 < Kv)) : true;
    const float* bp = Bp + (size_t)(ok ? k0 : 0) * ldb + bnc;
#pragma unroll
    for (int i = 0; i < 8; ++i) {
      float4 v = *(const float4*)bp;
      bp += ldb;
      rb[i] = ok ? v : float4{0.f, 0.f, 0.f, 0.f};
    }
  };
  fetch(0);
  for (int kt = 0; kt < nk; ++kt) {
    al.prep(kt * 64 + akc);
#pragma unroll
    for (int i = 0; i < 4; ++i) *(bf16x8*)&As[arow + 32 * i][akc] = al.finish(ra[i]);
    {
      bf16x8 v0 = pack8bf(rb[0].x, rb[1].x, rb[2].x, rb[3].x, rb[4].x, rb[5].x, rb[6].x, rb[7].x);
      bf16x8 v1 = pack8bf(rb[0].y, rb[1].y, rb[2].y, rb[3].y, rb[4].y, rb[5].y, rb[6].y, rb[7].y);
      bf16x8 v2 = pack8bf(rb[0].z, rb[1].z, rb[2].z, rb[3].z, rb[4].z, rb[5].z, rb[6].z, rb[7].z);
      bf16x8 v3 = pack8bf(rb[0].w, rb[1].w, rb[2].w, rb[3].w, rb[4].w, rb[5].w, rb[6].w, rb[7].w);
      *(bf16x8*)&Bs[bnq * 4 + 0][bkg * 8] = v0;
      *(bf16x8*)&Bs[bnq * 4 + 1][bkg * 8] = v1;
      *(bf16x8*)&Bs[bnq * 4 + 2][bkg * 8] = v2;
      *(bf16x8*)&Bs[bnq * 4 + 3][bkg * 8] = v3;
    }
    __syncthreads();
    if (kt + 1 < nk) fetch(kt + 1);
#pragma unroll
    for (int ks = 0; ks < 2; ++ks) {
      bf16x8 af[4], bfr[4];
#pragma unroll
      for (int i = 0; i < 4; ++i) af[i] = *(const bf16x8*)&As[wm * 64 + i * 16 + (lane & 15)][ks * 32 + (lane >> 4) * 8];
#pragma unroll
      for (int j = 0; j < 4; ++j) bfr[j] = *(const bf16x8*)&Bs[wn * 64 + j * 16 + (lane & 15)][ks * 32 + (lane >> 4) * 8];
#pragma unroll
      for (int i = 0; i < 4; ++i)
#pragma unroll
        for (int j = 0; j < 4; ++j) acc[i][j] = __builtin_amdgcn_mfma_f32_16x16x32_bf16(bfr[j], af[i], acc[i][j], 0, 0, 0);
    }
    __syncthreads();
  }
#pragma unroll
  for (int i = 0; i < 4; ++i)
#pragma unroll
    for (int j = 0; j < 4; ++j) ep(m0 + wm * 64 + i * 16 + (lane & 15), n0 + wn * 64 + j * 16 + (lane >> 4) * 4, acc[i][j]);
}

static constexpr int GBN = 256;
template <class EP>
DEV void gemm_tile_bt(const bf16_t* __restrict__ Ap, int lda, const bf16_t* __restrict__ Bt, int K, int m0, int n0, const EP& ep, char* smem, const int tid) {
  bf16_t (*As)[48] = (bf16_t (*)[48])smem;
  bf16_t (*Bs)[48] = (bf16_t (*)[48])(smem + 128 * 48 * 2);
  const int lane = tid & 63, w = tid >> 6, wm = w >> 1, wn = w & 1;
  f32x4 acc[4][8];
#pragma unroll
  for (int i = 0; i < 4; ++i)
#pragma unroll
    for (int j = 0; j < 8; ++j) acc[i][j] = f32x4{0.f, 0.f, 0.f, 0.f};
  bf16x8 ra0[2], rb0[4];
  const int ari = tid >> 2;
  const int arow = (ari & ~3) | ((ari & 1) << 1) | ((ari >> 1) & 1), akc = (tid & 3) * 8;
  const int nk = K >> 5;
  const bf16_t* Ag = Ap + (size_t)(m0 + arow) * lda + akc;
  const bf16_t* Bg = Bt + (size_t)(n0 + arow) * K + akc;
#define BT_FETCH(kt, ra, rb)                                                                      \
  {                                                                                                \
    _Pragma("unroll") for (int i = 0; i < 2; ++i) ra[i] = *(const bf16x8*)(Ag + (size_t)(64 * i) * lda + (kt) * 32); \
    _Pragma("unroll") for (int i = 0; i < 4; ++i) rb[i] = *(const bf16x8*)(Bg + (size_t)(64 * i) * K + (kt) * 32);   \
  }
#define BT_STEP(kt, ra, rb)                                                                        \
  {                                                                                                \
    _Pragma("unroll") for (int i = 0; i < 2; ++i) *(bf16x8*)&As[arow + 64 * i][akc] = ra[i];      \
    _Pragma("unroll") for (int i = 0; i < 4; ++i) *(bf16x8*)&Bs[arow + 64 * i][akc] = rb[i];      \
    __syncthreads();                                                                               \
    if ((kt) + 1 < nk) BT_FETCH((kt) + 1, ra, rb)                                                  \
    {                                                                                              \
      bf16x8 af[4];                                                                                \
      _Pragma("unroll") for (int i = 0; i < 4; ++i) af[i] = *(const bf16x8*)&As[wm * 64 + i * 16 + (lane & 15)][(lane >> 4) * 8];  \
      _Pragma("unroll") for (int jh = 0; jh < 2; ++jh) {                                           \
        bf16x8 bfr[4];                                                                             \
        _Pragma("unroll") for (int j = 0; j < 4; ++j) bfr[j] = *(const bf16x8*)&Bs[wn * 128 + (jh * 4 + j) * 16 + (lane & 15)][(lane >> 4) * 8]; \
        _Pragma("unroll") for (int i = 0; i < 4; ++i)                                              \
          _Pragma("unroll") for (int j = 0; j < 4; ++j) acc[i][jh * 4 + j] = __builtin_amdgcn_mfma_f32_16x16x32_bf16(bfr[j], af[i], acc[i][jh * 4 + j], 0, 0, 0); \
        __builtin_amdgcn_sched_barrier(0);                                                         \
      }                                                                                            \
    }                                                                                              \
    __syncthreads();                                                                               \
  }
  BT_FETCH(0, ra0, rb0)
  for (int kt = 0; kt < nk; ++kt) {
    BT_STEP(kt, ra0, rb0)
  }
#undef BT_FETCH
#undef BT_STEP
#pragma unroll
  for (int i = 0; i < 4; ++i)
#pragma unroll
    for (int j = 0; j < 8; ++j) ep(m0 + wm * 64 + i * 16 + (lane & 15), n0 + wn * 128 + j * 16 + (lane >> 4) * 4, acc[i][j]);
}

DEV void convert_wt(const float* W, int K, int N, bf16_t* WT, int worker, int nworkers, char* smem, int tid) {
  const int nt_n = N >> 6;
  const int total = (K >> 6) * nt_n;
  for (int t0 = worker; t0 < total; t0 += 4 * nworkers) {
    const float* in[4] = {W, W, W, W};
    bf16_t* out[4] = {WT, WT, WT, WT};
    size_t rc[4], oc[4];
    int nvalid = 0;
#pragma unroll
    for (int q = 0; q < 4; ++q) {
      const int t = t0 + q * nworkers;
      const int tc = t < total ? t : t0;
      const int kt = tc / nt_n, nt = tc % nt_n;
      rc[q] = (size_t)(kt * 64) * N + nt * 64;
      oc[q] = (size_t)(nt * 64) * K + kt * 64;
      nvalid += (t < total) ? 1 : 0;
    }
    transpose_tiles4(in, rc, N, out, oc, K, nvalid, smem, tid);
  }
}

DEV void tile_map(int t, int lognt, int& mt, int& nt) {
  if (gridDim.x == 512) {
    const int r = t >> 9, b = t & 511;
    const int xcd = b & 7, slot = b >> 3;
    const int logpc = lognt - 3;
    const int pc = xcd & ((1 << logpc) - 1), pr = xcd >> logpc;
    mt = r * (64 >> logpc) + pr * 8 + (slot >> 3);
    nt = pc * 8 + (slot & 7);
  } else {
    nt = t & ((1 << lognt) - 1);
    mt = t >> lognt;
  }
}
static constexpr int MT = TTOK / 128;

DEV void phase_lru_in(const int wv, const Params& p, int j, char* smem) {
  const int tid = TID, bid = BID;
  EpXZ ep{p.BA, p.BB};
  const bf16_t* Bt = p.WB + ((size_t)DM * EI);
  for (int t = bid; t < MT * 32; t += gridDim.x) {
    int nt, mt; tile_map(t, 5, mt, nt);
    gemm_tile_bt(p.H, DM, Bt, DM, mt * 128, nt * GBN, ep, smem, tid);
  }
}
DEV void phase_out_proj(const int wv, const Params& p, const bf16_t* A, const bf16_t* Wt, float* Mout, char* smem) {
  const int tid = TID, bid = BID;
  EpF32 ep{Mout, DM};
  for (int t = bid; t < MT * 8; t += gridDim.x) {
    int nt, mt; tile_map(t, 3, mt, nt); mt = (TTOK / 128 - 1) - mt;
    gemm_tile_bt(A, EI, Wt, EI, mt * 128, nt * GBN, ep, smem, tid);
  }
}
DEV void phase_conv(const int wv, const Params& p, int j, char* smem) {
  const bf16_t* XB = p.BA;
  bf16_t* XC = p.BC;
  const float* cw = p.lru_conv_w + (size_t)j * 4 * EI;
  const float* cb = p.lru_conv_b + (size_t)j * EI;
  const int total = TTOK * 512;
  const int tid = TID, bid = BID;
  for (int idx = bid * 256 + tid; idx < total; idx += gridDim.x * 256) {
    int g = idx >> 9, e = (idx & 511) * 8;
    int t, L;
    if (g < TCTX) { t = g & 255; L = 256; } else { t = (g - TCTX) & 4095; L = 4096; }
    float acc[8];
    {
      float4 b0 = *(const float4*)(cb + e), b1 = *(const float4*)(cb + e + 4);
      acc[0] = b0.x; acc[1] = b0.y; acc[2] = b0.z; acc[3] = b0.w; acc[4] = b1.x; acc[5] = b1.y; acc[6] = b1.z; acc[7] = b1.w;
    }
#pragma unroll
    for (int tap = 0; tap < 4; ++tap) {
      int tt = t + tap - 2;
      if (tt >= 0 && tt < L) {
        bf16x8 xv = *(const bf16x8*)(XB + (size_t)(g + tap - 2) * EI + e);
        float4 w0 = *(const float4*)(cw + tap * EI + e), w1 = *(const float4*)(cw + tap * EI + e + 4);
        acc[0] += w0.x * bfs(xv[0]); acc[1] += w0.y * bfs(xv[1]); acc[2] += w0.z * bfs(xv[2]); acc[3] += w0.w * bfs(xv[3]);
        acc[4] += w1.x * bfs(xv[4]); acc[5] += w1.y * bfs(xv[5]); acc[6] += w1.z * bfs(xv[6]); acc[7] += w1.w * bfs(xv[7]);
      }
    }
    *(bf16x8*)(XC + (size_t)g * EI + e) = pack8bf(acc[0], acc[1], acc[2], acc[3], acc[4], acc[5], acc[6], acc[7]);
  }
  convert_wt(p.lru_w_out + (size_t)j * EI * DM, EI, DM, p.WB + ((size_t)DM * EI), bid, gridDim.x, smem, tid);
}

DEV void lru_item(const Params& p, int j, int item, char* smem, const int tid) {
  float (*sA)[64][64] = (float (*)[64][64])smem;
  float (*sU)[64][64] = (float (*)[64][64])(smem + 32768);
  const bf16_t* XC = p.BC;
  const bf16_t* ZB = p.BB;
  bf16_t* Y = p.BA;
  const int lane = tid & 63, w = tid >> 6;
  int s, n, sl;
  if (item < 256) { s = 32 + (item >> 6); n = (item & 63) >> 2; sl = item & 3; }
  else { int i2 = item - 256; s = i2 >> 6; n = (i2 & 63) >> 2; sl = i2 & 3; }
  const int L = s < 32 ? 256 : 4096;
  const size_t g0 = s < 32 ? (size_t)s * 256 : (size_t)TCTX + (size_t)(s - 32) * 4096;
  const int NT = L >> 6;
  const int e0 = n * 256 + sl * 64;
  const int sd = tid >> 6, sch = tid & 63;
  float hst = 0.f;
  if (tid < 128 && s >= 32) hst = p.state_lru[(size_t)(((s - 32) * 2 + j) * 2 + sd) * EI + e0 + sch];
  const int ch = w * 16 + (lane & 15);
  float gbr[2], gbi[2], sp[2];
#pragma unroll
  for (int d = 0; d < 2; ++d) {
    gbr[d] = p.lru_gate_b[(size_t)((j * 2 + d) * 2 + 0) * EI + e0 + ch];
    gbi[d] = p.lru_gate_b[(size_t)((j * 2 + d) * 2 + 1) * EI + e0 + ch];
    float lam = p.lru_lambda[(size_t)(j * 2 + d) * EI + e0 + ch];
    float xx = -lam;
    { float tt = __expf(xx); float ser = tt * (1.f + tt * (-0.5f + tt * (0.33333334f + tt * (-0.25f + tt * 0.2f)))); sp[d] = xx > 20.f ? xx : (tt < 0.05f ? ser : __logf(1.f + tt)); }
  }
  for (int it = 0; it < NT; ++it) {
    const bool first = it < (NT >> 1);
    bf16x8 partv[2][2], zv[2][2];
    {
      const size_t gt0 = g0 + (size_t)it * 64, gt1 = g0 + (size_t)(NT - 1 - it) * 64;
      bf16_t (*At)[64][264] = (bf16_t (*)[64][264])smem;
      bf16x8 areg[2][8];
#pragma unroll
      for (int i = 0; i < 8; ++i) {
        const int id = tid + 256 * i;
        const int row = id >> 5, c8 = (id & 31) * 8;
        areg[0][i] = *(const bf16x8*)(XC + (gt0 + row) * EI + n * 256 + c8);
        areg[1][i] = *(const bf16x8*)(XC + (gt1 + row) * EI + n * 256 + c8);
      }
      const bf16_t* Bw0r = p.WB + ((((size_t)0 * 2 + 0) * 16 + n) * 256 + (sl * 64 + ch)) * 256 + (lane >> 4) * 8;
      const bf16_t* Bw0i = p.WB + ((((size_t)0 * 2 + 1) * 16 + n) * 256 + (sl * 64 + ch)) * 256 + (lane >> 4) * 8;
      const bf16_t* Bw1r = p.WB + ((((size_t)1 * 2 + 0) * 16 + n) * 256 + (sl * 64 + ch)) * 256 + (lane >> 4) * 8;
      const bf16_t* Bw1i = p.WB + ((((size_t)1 * 2 + 1) * 16 + n) * 256 + (sl * 64 + ch)) * 256 + (lane >> 4) * 8;
      bf16x8 brA[4], biA[4], brB[4], biB[4];
#define LRU_LOADB(BR, BI, PR, PI, half) \
  _Pragma("unroll") for (int ks = 0; ks < 4; ++ks) { BR[ks] = *(const bf16x8*)(PR + ((half) * 4 + ks) * 32); BI[ks] = *(const bf16x8*)(PI + ((half) * 4 + ks) * 32); }
#define LRU_MMA(d, half, BR, BI)                                                                                  \
  _Pragma("unroll") for (int ks = 0; ks < 4; ++ks)                                                                \
    _Pragma("unroll") for (int mb = 0; mb < 4; ++mb) {                                                            \
      const bf16x8 af = *(const bf16x8*)&At[d][mb * 16 + (lane & 15)][((half) * 4 + ks) * 32 + (lane >> 4) * 8]; \
      ar[d][mb] = __builtin_amdgcn_mfma_f32_16x16x32_bf16(af, BR[ks], ar[d][mb], 0, 0, 0);                        \
      ai[d][mb] = __builtin_amdgcn_mfma_f32_16x16x32_bf16(af, BI[ks], ai[d][mb], 0, 0, 0);                        \
    }
      LRU_LOADB(brA, biA, Bw0r, Bw0i, 0)
      LRU_LOADB(brB, biB, Bw0r, Bw0i, 1)
      __builtin_amdgcn_sched_barrier(0);
#pragma unroll
      for (int i = 0; i < 8; ++i) {
        const int id = tid + 256 * i;
        const int row = id >> 5, c8 = (id & 31) * 8;
        *(bf16x8*)&At[0][row][c8] = areg[0][i];
        *(bf16x8*)&At[1][row][c8] = areg[1][i];
      }
      __syncthreads();
      f32x4 ar[2][4], ai[2][4];
#pragma unroll
      for (int d = 0; d < 2; ++d)
#pragma unroll
        for (int mb = 0; mb < 4; ++mb) { ar[d][mb] = f32x4{0.f, 0.f, 0.f, 0.f}; ai[d][mb] = f32x4{0.f, 0.f, 0.f, 0.f}; }
      LRU_MMA(0, 0, brA, biA)
      __builtin_amdgcn_sched_barrier(0);
      LRU_LOADB(brA, biA, Bw1r, Bw1i, 0)
      LRU_MMA(0, 1, brB, biB)
      __builtin_amdgcn_sched_barrier(0);
      LRU_LOADB(brB, biB, Bw1r, Bw1i, 1)
      LRU_MMA(1, 0, brA, biA)
      __builtin_amdgcn_sched_barrier(0);
      LRU_MMA(1, 1, brB, biB)
#undef LRU_LOADB
#undef LRU_MMA
      unsigned short xfr[2][4][4];
#pragma unroll
      for (int d = 0; d < 2; ++d)
#pragma unroll
        for (int mb = 0; mb < 4; ++mb)
#pragma unroll
          for (int r = 0; r < 4; ++r) xfr[d][mb][r] = At[d][mb * 16 + (lane >> 4) * 4 + r][sl * 64 + ch];
      if (!first) {
#pragma unroll
        for (int d = 0; d < 2; ++d) {
          const size_t gt = d == 0 ? gt0 : gt1;
#pragma unroll
          for (int i = 0; i < 2; ++i) {
            int idx = tid + 256 * i;
            int tok = idx >> 3, cc = idx & 7;
            size_t g = gt + tok;
            partv[d][i] = *(const bf16x8*)(Y + g * EI + e0 + cc * 8);
            zv[d][i] = *(const bf16x8*)(ZB + g * EI + e0 + cc * 8);
          }
        }
      }
      __syncthreads();
#pragma unroll
      for (int d = 0; d < 2; ++d)
#pragma unroll
        for (int mb = 0; mb < 4; ++mb)
#pragma unroll
          for (int r = 0; r < 4; ++r) {
            int tok = mb * 16 + (lane >> 4) * 4 + r;
            float rg = sigmoidf_(ar[d][mb][r] + gbr[d]);
            float ig = sigmoidf_(ai[d][mb][r] + gbi[d]);
            float la = -8.f * rg * sp[d];
            float a = __expf(la);
            float x2 = -2.f * la;
            float poly = x2 * (1.f + x2 * (-0.5f + x2 * (0.16666667f + x2 * (-0.041666668f + x2 * (0.0083333338f + x2 * (-0.0013888889f))))));
            float om = x2 < 0.4f ? poly : 1.f - __expf(-x2);
            float u = __builtin_amdgcn_sqrtf(fmaxf(om, 0.f)) * (ig * bf2f(xfr[d][mb][r]));
            sA[d][tok][ch] = a;
            sU[d][tok][ch] = u;
          }
    }
    __syncthreads();
    if (tid < 128) {
#pragma unroll 1
      for (int c0 = 0; c0 < 64; c0 += 16) {
        float av[16], uv[16];
#pragma unroll
        for (int t = 0; t < 16; ++t) {
          const int tok = sd == 0 ? c0 + t : 63 - (c0 + t);
          av[t] = sA[sd][tok][sch];
          uv[t] = sU[sd][tok][sch];
        }
#pragma unroll
        for (int t = 0; t < 16; ++t) { hst = av[t] * hst + uv[t]; uv[t] = hst; }
#pragma unroll
        for (int t = 0; t < 16; ++t) {
          const int tok = sd == 0 ? c0 + t : 63 - (c0 + t);
          sU[sd][tok][sch] = uv[t];
        }
      }
    }
    __syncthreads();
#pragma unroll
    for (int d = 0; d < 2; ++d) {
      const int tile = d == 0 ? it : NT - 1 - it;
#pragma unroll
      for (int i = 0; i < 2; ++i) {
        int idx = tid + 256 * i;
        int tok = idx >> 3, cc = idx & 7;
        size_t g = g0 + (size_t)tile * 64 + tok;
        float4 y0 = *(const float4*)&sU[d][tok][cc * 8], y1 = *(const float4*)&sU[d][tok][cc * 8 + 4];
        float y[8] = {y0.x, y0.y, y0.z, y0.w, y1.x, y1.y, y1.z, y1.w};
        bf16_t* yp = Y + g * EI + e0 + cc * 8;
        if (first) {
          *(bf16x8*)yp = pack8bf(y[0], y[1], y[2], y[3], y[4], y[5], y[6], y[7]);
        } else {
          bf16x8 part = partv[d][i], z = zv[d][i];
          *(bf16x8*)yp = pack8bf((y[0] + bfs(part[0])) * bfs(z[0]), (y[1] + bfs(part[1])) * bfs(z[1]), (y[2] + bfs(part[2])) * bfs(z[2]),
                                 (y[3] + bfs(part[3])) * bfs(z[3]), (y[4] + bfs(part[4])) * bfs(z[4]), (y[5] + bfs(part[5])) * bfs(z[5]),
                                 (y[6] + bfs(part[6])) * bfs(z[6]), (y[7] + bfs(part[7])) * bfs(z[7]));
        }
      }
    }
    __syncthreads();
  }
  if (tid < 128 && s < 32) p.out[OFF_LRU + (size_t)((s * 2 + j) * 2 + sd) * EI + e0 + sch] = hst;
}
DEV void phase_lru_scan(const int wv, const Params& p, int j, char* smem) {
  const int tid = TID;
  const int G = gridDim.x, b = BID;
  int item, step;
  if (G >= 320) { if (b < 256) { item = b; step = 1 << 20; } else { item = b; step = G - 256; } }
  else { item = b; step = G; }
  for (; item < 2304; item += step) lru_item(p, j, item, smem, tid);
}

DEV void phase_mix(const int wv, const Params& p, int j) {
  const int tid = TID, bid = BID;
  const float* mu = p.mu + (size_t)j * 5 * DM;
  const size_t HALF = (size_t)TTOK * DM;
  bf16_t* dst[5] = {p.BA, p.BB + HALF, p.BA + HALF, p.BB, p.BC};
  for (int idx = bid * 256 + tid; idx < TTOK * 256; idx += gridDim.x * 256) {
    const int row = idx >> 8, k = (idx & 255) * 8;
    int srow; bool valid;
    if (row < TCTX) {
      int t = row & 255;
      if (k < 1024) { srow = row - 1; valid = t > 0; } else { srow = row + 1; valid = t < 255; }
    } else {
      int t = (row - TCTX) & 4095;
      int q = k >> 9;
      if (q == 0) { srow = row - 1; valid = (t & 63) != 0; }
      else if (q == 1) { srow = row + 1; valid = (t & 63) != 63; }
      else if (q == 2) { srow = row - 64; valid = t >= 64; }
      else { srow = row + 64; valid = t < 4096 - 64; }
    }
    bf16x8 hv = *(const bf16x8*)(p.H + (size_t)row * DM + k);
    bf16x8 sv = *(const bf16x8*)(p.H + (size_t)(valid ? srow : row) * DM + k);
    float h[8], dx[8];
#pragma unroll
    for (int i = 0; i < 8; ++i) { h[i] = bfs(hv[i]); dx[i] = valid ? bfs(sv[i]) - h[i] : -h[i]; }
#pragma unroll
    for (int m = 0; m < 5; ++m) {
      float4 m0 = *(const float4*)(mu + m * DM + k), m1 = *(const float4*)(mu + m * DM + k + 4);
      *(bf16x8*)(dst[m] + (size_t)row * DM + k) =
          pack8bf(h[0] + dx[0] * m0.x, h[1] + dx[1] * m0.y, h[2] + dx[2] * m0.z, h[3] + dx[3] * m0.w,
                  h[4] + dx[4] * m1.x, h[5] + dx[5] * m1.y, h[6] + dx[6] * m1.z, h[7] + dx[7] * m1.w);
    }
  }
}
DEV void phase_rwkv_ga(const int wv, const Params& p, int j, char* smem) {
  const int tid = TID, bid = BID;
  const size_t HALF = (size_t)TTOK * DM;
  const int T0 = (j == 0) ? MT * 16 : 0;
  const int nsmall = (j == 0) ? 4 : 5;
  const int total = T0 + MT * nsmall;
  for (int t = bid; t < total; t += gridDim.x) {
    if (t < T0) {
      int nt, mt; tile_map(t, 4, mt, nt); mt = (TTOK / 128 - 1) - mt;
      EpBF16 ep{p.VF, EI};
      gemm_tile_bt(p.BB, DM, p.WB, DM, mt * 128, nt * GBN, ep, smem, tid);
    } else {
      int loc = t - T0;
      int job = loc / MT, mt = loc % MT;
      const bf16_t* Aj; const float* Bj; int ldbj = 128, nvj = 128, tanhj = 0; bf16_t* Cj;
      if (job < 2) { Aj = p.BB + HALF; Bj = p.w1 + (size_t)(j * 2 + job) * DM * 128; Cj = p.LORA1 + job * 128; tanhj = 1; }
      else if (job < 4) { Aj = p.BC; Bj = p.a1 + (size_t)(j * 2 + (job - 2)) * DM * 128; Cj = p.LORA1 + 256 + (job - 2) * 128; }
      else { Aj = p.BB; Bj = p.v1; ldbj = 96; nvj = 96; Cj = p.LORA1 + 512; }
      ALPlain alj{Aj, DM};
      EpLora ep{Cj, tanhj};
      gemm_tile<true>(alj, Bj, ldbj, DM, nvj, DM, mt * 128, 0, ep, smem, tid);
    }
  }
}
DEV void phase_rwkv_gb(const int wv, const Params& p, char* smem) {
  const int tid = TID, bid = BID;
  ALPlain all{p.LORA1 + 512, 640};
  EpVmix ep1{p.BC, p.v0};
  EpVmixV ep2{p.VF, p.BC};
  for (int t = bid; t < MT * 16; t += gridDim.x) {
    int nt, mt; tile_map(t, 4, mt, nt);
    gemm_tile<true>(all, p.v2, EI, 96, EI, 128, mt * 128, nt * GBN, ep1, smem, tid);
    gemm_tile<true>(all, p.v2, EI, 96, EI, 128, mt * 128, nt * GBN + 128, ep1, smem, tid);
    __syncthreads();
    gemm_tile_bt(p.BB, DM, p.WB, DM, mt * 128, nt * GBN, ep2, smem, tid);
  }
}
DEV void phase_rwkv_gc(const int wv, const Params& p, int j, char* smem) {
  const int tid = TID, bid = BID;
  const size_t HALF = (size_t)TTOK * DM;
  EpBF16 epr{p.BB, EI}, epk{p.BC, EI};
  for (int t = bid; t < MT * 32; t += gridDim.x) {
    int job = t / (MT * 16), loc = t % (MT * 16);
    int nt, mt; tile_map(loc, 4, mt, nt); mt = (TTOK / 128 - 1) - mt;
    if (job == 0) gemm_tile_bt(p.BA, DM, p.WB + ((size_t)DM * EI), DM, mt * 128, nt * GBN, epr, smem, tid);
    else gemm_tile_bt(p.BA + HALF, DM, p.WB + 2 * ((size_t)DM * EI), DM, mt * 128, nt * GBN, epk, smem, tid);
  }
}
DEV void phase_rwkv_gz(const int wv, const Params& p, int j, char* smem) {
  const int tid = TID, bid = BID;
  EpZ ep{p.BA};
  for (int t = bid; t < MT * 16; t += gridDim.x) {
    int nt, mt; tile_map(t, 4, mt, nt);
    gemm_tile_bt(p.H, DM, p.WB, DM, mt * 128, nt * GBN, ep, smem, tid);
  }
}

DEV void rwkv_item(const Params& p, int j, int item, char* smem, const int tid) {
  const int lane = tid & 63, w = tid >> 6;
  const int d = w & 1;
  const bool producer = w >= 2;
  float* rec = (float*)smem;
  float* yout = rec + 12288;
  float* bsl = yout + 2048;
  const bf16_t* R = p.BB;
  const bf16_t* Kb = p.BC;
  const bf16_t* V = p.VF;
  bf16_t* Y = p.BA;
  int s, hd;
  if (item < 256) { s = 32 + (item >> 6); hd = item & 63; } else { s = (item - 256) >> 6; hd = (item - 256) & 63; }
  const int L = s < 32 ? 256 : 4096;
  const size_t g0 = s < 32 ? (size_t)s * 256 : (size_t)TCTX + (size_t)(s - 32) * 4096;
  const int NT = L >> 3;
  const int el = hd * 64 + lane;
  if (s >= 32) __builtin_amdgcn_s_setprio(3);

  if (!producer) {
    float S[64];
    if (s >= 32) {
      const float* sp = p.state_rwkv + ((size_t)((((s - 32) * 2 + j) * 2 + d) * 64 + hd)) * 4096 + lane * 64;
#pragma unroll
      for (int k = 0; k < 64; k += 4) { float4 v = *(const float4*)(sp + k); S[k] = v.x; S[k + 1] = v.y; S[k + 2] = v.z; S[k + 3] = v.w; }
    } else {
#pragma unroll
      for (int k = 0; k < 64; ++k) S[k] = 0.f;
    }
    const int l4 = (lane & 3) * 4;
#define DPP_FMAC(acc, x, sv, J) asm("v_fmac_f32_dpp %0, %1, %2 quad_perm:[" #J "," #J "," #J "," #J "] row_mask:0xf bank_mask:0xf" : "+v"(acc) : "v"(x), "v"(sv))
#define DPP_MULS(sv, x, J) asm("v_mul_f32_dpp %0, %1, %0 quad_perm:[" #J "," #J "," #J "," #J "] row_mask:0xf bank_mask:0xf" : "+v"(sv) : "v"(x))
#define UPD_E(C, k, comp, J)            \
  DPP_FMAC(S[k], C[0].comp, sa, J);     \
  DPP_FMAC(S[k], C[1].comp, vq, J);
#define UPD_Q(C, m, J)                    \
  UPD_E(C, 16 * (m) + 4 * (J) + 0, x, J)  \
  UPD_E(C, 16 * (m) + 4 * (J) + 1, y, J)  \
  UPD_E(C, 16 * (m) + 4 * (J) + 2, z, J)  \
  UPD_E(C, 16 * (m) + 4 * (J) + 3, w, J)
#define UPD_M(C, m) UPD_Q(C, m, 0) UPD_Q(C, m, 1) UPD_Q(C, m, 2) UPD_Q(C, m, 3)
#define DOT_M(acc0, acc1, V, m)                                                               \
  _Pragma("unroll") for (int cc = 0; cc < 4; ++cc) {                                          \
    acc0 += fl2_t{S[16 * (m) + 4 * cc], S[16 * (m) + 4 * cc + 1]} * fl2_t{V[cc].x, V[cc].y};  \
    acc1 += fl2_t{S[16 * (m) + 4 * cc + 2], S[16 * (m) + 4 * cc + 3]} * fl2_t{V[cc].z, V[cc].w}; \
  }
#define MUL_M(V, m)                                                                            \
  _Pragma("unroll") for (int cc = 0; cc < 4; ++cc) {                                          \
    fl2_t t0 = fl2_t{S[16 * (m) + 4 * cc], S[16 * (m) + 4 * cc + 1]} * fl2_t{V[cc].x, V[cc].y};  \
    fl2_t t1 = fl2_t{S[16 * (m) + 4 * cc + 2], S[16 * (m) + 4 * cc + 3]} * fl2_t{V[cc].z, V[cc].w}; \
    S[16 * (m) + 4 * cc] = t0.x; S[16 * (m) + 4 * cc + 1] = t0.y; S[16 * (m) + 4 * cc + 2] = t1.x; S[16 * (m) + 4 * cc + 3] = t1.y; \
  }
#define LOAD_V(V, base, m) _Pragma("unroll") for (int cc = 0; cc < 4; ++cc) V[cc] = *(const float4*)((base) + 16 * (m) + 4 * cc);
#define LOAD_C(C, vt, m)                         \
  C[0] = *(const float4*)((vt) + 128 + 16 * (m)); \
  C[1] = *(const float4*)((vt) + 192 + 16 * (m));
    __syncthreads();
    for (int i = 0; i <= NT; ++i) {
      if (i < NT) {
        const int b = i & 1;
        const float* ub0 = rec + ((b * 2 + d) * 8) * 384;
        float4 A0[4], A1[4], R0[4], W0[4], W1[4], C0[2], C1[2];
        LOAD_V(A0, ub0 + 64, 0)
        LOAD_V(A1, ub0 + 64, 1)
#pragma unroll 1
        for (int q = 0; q < 8; ++q) {
          const float* ub = ub0 + q * 384;
          const float* vt = ub + l4;
          const float vq = ub[320 + lane];
          fl2_t acc0 = {0.f, 0.f}, acc1 = {0.f, 0.f};
          __builtin_amdgcn_sched_barrier(0);
          LOAD_V(R0, ub + 64, 2)
          DOT_M(acc0, acc1, A0, 0)
          __builtin_amdgcn_sched_barrier(0);
          LOAD_V(A0, ub + 64, 3)
          DOT_M(acc0, acc1, A1, 1)
          __builtin_amdgcn_sched_barrier(0);
          LOAD_C(C0, vt, 0)
          LOAD_V(W0, ub, 0)
          DOT_M(acc0, acc1, R0, 2)
          __builtin_amdgcn_sched_barrier(0);
          LOAD_C(C1, vt, 1)
          LOAD_V(W1, ub, 1)
          LOAD_V(R0, ub + 256, 0)
          DOT_M(acc0, acc1, A0, 3)
          const float sa = (acc0.x + acc0.y) + (acc1.x + acc1.y);
          fl2_t y0 = {0.f, 0.f}, y1 = {0.f, 0.f};
          __builtin_amdgcn_sched_barrier(0);
          MUL_M(W0, 0)
          UPD_M(C0, 0)
          LOAD_C(C0, vt, 2)
          LOAD_V(W0, ub, 2)
          LOAD_V(A1, ub + 256, 1)
          DOT_M(y0, y1, R0, 0)
          __builtin_amdgcn_sched_barrier(0);
          MUL_M(W1, 1)
          UPD_M(C1, 1)
          LOAD_C(C1, vt, 3)
          LOAD_V(W1, ub, 3)
          LOAD_V(R0, ub + 256, 2)
          DOT_M(y0, y1, A1, 1)
          __builtin_amdgcn_sched_barrier(0);
          MUL_M(W0, 2)
          UPD_M(C0, 2)
          LOAD_V(A1, ub + 256, 3)
          DOT_M(y0, y1, R0, 2)
          __builtin_amdgcn_sched_barrier(0);
          MUL_M(W1, 3)
          UPD_M(C1, 3)
          LOAD_V(A0, ub + 384 + 64, 0)
          DOT_M(y0, y1, A1, 3)
          __builtin_amdgcn_sched_barrier(0);
          LOAD_V(A1, ub + 384 + 64, 1)
          yout[((b * 2 + d) * 8 + q) * 64 + lane] = (y0.x + y0.y) + (y1.x + y1.y);
        }
      }
      __syncthreads();
    }
#undef MUL_M
#undef DOT_M
#undef LOAD_V
#undef DPP_FMAC
#undef DPP_MULS
#undef UPD_E
#undef UPD_Q
#undef UPD_M
#undef LOAD_C
    if (s < 32) {
      float* dst = p.out + OFF_RWKV + ((size_t)(((s * 2 + j) * 2 + d) * 64 + hd)) * 4096 + lane * 64;
#pragma unroll
      for (int k = 0; k < 64; k += 4) *(float4*)(dst + k) = float4{S[k], S[k + 1], S[k + 2], S[k + 3]};
    }
  } else {
    const int hi = lane >> 5;
    const int c16 = lane & 15;
    const int qb = ((lane >> 4) & 1) * 4;
    float w0c[2], a0c[2], kkc[2], kac[2], rkc[2];
#pragma unroll
    for (int nbi = 0; nbi < 2; ++nbi) {
      const int e = hd * 64 + (hi * 2 + nbi) * 16 + c16;
      w0c[nbi] = p.w0[(size_t)(j * 2 + d) * EI + e];
      a0c[nbi] = p.a0[(size_t)(j * 2 + d) * EI + e];
      kkc[nbi] = p.k_k[(size_t)j * EI + e];
      kac[nbi] = p.k_a[(size_t)j * EI + e];
      rkc[nbi] = p.r_k[(size_t)j * EI + e];
    }
    const float lnw = p.ln_w[(size_t)j * EI + el];
    const float lnb = p.ln_b[(size_t)j * EI + el];
    const bf16_t* W2 = p.W2T + ((size_t)(j * 2 + d) * EI + hd * 64 + c16) * 128 + (lane >> 4) * 8;
    const bf16_t* A2 = p.A2T + ((size_t)(j * 2 + d) * EI + hd * 64 + c16) * 128 + (lane >> 4) * 8;
    float* BSme = p.BS + (size_t)d * TTOK * 64;
    const float* BSot = p.BS + (size_t)(1 - d) * TTOK * 64;

    auto tile_g = [&](int i, int q) -> size_t {
      return d == 0 ? g0 + (size_t)i * 8 + q : g0 + (size_t)(L - 1 - i * 8 - q);
    };
    bf16x8 xw[4], xa[4];
    unsigned short rr_[2][4], kx_[2][4], vv_[2][4];
    unsigned short ypart[8];
    float bso[8];
    auto prefetch_tile = [&](const int in) {
      const int inc = in < NT ? in : NT - 1;
      const bf16_t* Ap = p.LORA1 + tile_g(inc, lane & 7) * 640 + (lane >> 4) * 8;
#pragma unroll
      for (int ks = 0; ks < 4; ++ks) {
        xw[ks] = *(const bf16x8*)(Ap + d * 128 + ks * 32);
        xa[ks] = *(const bf16x8*)(Ap + 256 + d * 128 + ks * 32);
      }
    };
    auto load_part = [&](const int ip) {
#pragma unroll
      for (int q = 0; q < 8; ++q) {
        const size_t g = tile_g(ip, q);
        ypart[q] = Y[g * EI + el];
        bso[q] = BSot[g * 64 + hd];
      }
    };
    auto prod_iter = [&](const int ip, const int in) {
      const bool do_post = ip >= 0, do_prod = in < NT;
      const bool first = ip < (NT >> 1);
      if (do_post && !first) load_part(ip);
      bf16x8 bwA[4], baA[4];
#define LOAD_B(BW, BA_, ks)                                                  \
  _Pragma("unroll") for (int nb = 0; nb < 4; ++nb) {                         \
    BW[nb] = *(const bf16x8*)(W2 + (size_t)nb * 16 * 128 + (ks) * 32);       \
    BA_[nb] = *(const bf16x8*)(A2 + (size_t)nb * 16 * 128 + (ks) * 32);      \
  }
#define MFMA_B(BW, BA_, ks)                                                  \
  _Pragma("unroll") for (int nb = 0; nb < 4; ++nb) {                         \
    aw[nb] = __builtin_amdgcn_mfma_f32_16x16x32_bf16(xw[ks], BW[nb], aw[nb], 0, 0, 0);  \
    aa[nb] = __builtin_amdgcn_mfma_f32_16x16x32_bf16(xa[ks], BA_[nb], aa[nb], 0, 0, 0); \
  }
      if (do_prod) { LOAD_B(bwA, baA, 0) }
      __builtin_amdgcn_sched_barrier(0);
      if (do_post) {
        const int b = ip & 1;
#pragma unroll
        for (int q = 0; q < 8; ++q) {
          const size_t g = tile_g(ip, q);
          const float y = yout[((b * 2 + d) * 8 + q) * 64 + lane];
          const float bsq = bsl[(b * 2 + d) * 8 + q];
          if (first) {
            Y[g * EI + el] = f2bf(y);
            if (lane == 0) BSme[g * 64 + hd] = bsq;
          } else {
            const float vq = rec[((b * 2 + d) * 8 + q) * 384 + 320 + lane];
            const float yt = y + bf2f(ypart[q]);
            const float mean = wave_sum_fast(yt) * (1.f / 64.f);
            const float dv = yt - mean;
            const float var = wave_sum_fast(dv * dv) * (1.f / 64.f);
            const float yn = dv * __builtin_amdgcn_rsqf(var + 64e-5f) * lnw + lnb;
            Y[g * EI + el] = f2bf(yn + (bsq + bso[q]) * vq);
          }
        }
      }
      __builtin_amdgcn_sched_barrier(0);
      if (do_prod) {
        const int b = in & 1;
        f32x4 aw[4], aa[4];
#pragma unroll
        for (int nb = 0; nb < 4; ++nb) { aw[nb] = f32x4{0.f, 0.f, 0.f, 0.f}; aa[nb] = f32x4{0.f, 0.f, 0.f, 0.f}; }
#pragma unroll
        for (int nbi = 0; nbi < 2; ++nbi)
#pragma unroll
          for (int r = 0; r < 4; ++r) {
            const size_t g = tile_g(in, qb + r);
            const int e = hd * 64 + (hi * 2 + nbi) * 16 + c16;
            rr_[nbi][r] = R[g * EI + e];
            kx_[nbi][r] = Kb[g * EI + e];
            vv_[nbi][r] = V[g * EI + e];
          }
        MFMA_B(bwA, baA, 0)
        __builtin_amdgcn_sched_barrier(0);
        LOAD_B(bwA, baA, 1)
        MFMA_B(bwA, baA, 1)
        __builtin_amdgcn_sched_barrier(0);
        LOAD_B(bwA, baA, 2)
        MFMA_B(bwA, baA, 2)
        __builtin_amdgcn_sched_barrier(0);
        LOAD_B(bwA, baA, 3)
        MFMA_B(bwA, baA, 3)
        float dec[2][4], asg[2][4], kk[2][4], kd[2][4], rr[2][4], vv[2][4], ss[4], bs[4];
#pragma unroll
        for (int r = 0; r < 4; ++r) { ss[r] = 0.f; bs[r] = 0.f; }
#pragma unroll
        for (int nbi = 0; nbi < 2; ++nbi)
#pragma unroll
          for (int r = 0; r < 4; ++r) {
            const float wacc = hi ? aw[2 + nbi][r] : aw[nbi][r];
            const float aacc = hi ? aa[2 + nbi][r] : aa[nbi][r];
            dec[nbi][r] = __expf(-0.6065306597126334f * sigmoidf_(wacc + w0c[nbi]));
            asg[nbi][r] = sigmoidf_(aacc + a0c[nbi]);
            rr[nbi][r] = bf2f(rr_[nbi][r]);
            const float kx = bf2f(kx_[nbi][r]);
            vv[nbi][r] = bf2f(vv_[nbi][r]);
            kk[nbi][r] = kx * kkc[nbi];
            ss[r] += kk[nbi][r] * kk[nbi][r];
            kd[nbi][r] = kx * (1.f + (asg[nbi][r] - 1.f) * kac[nbi]);
            bs[r] += rr[nbi][r] * kd[nbi][r] * rkc[nbi];
          }
        {
          const bool qhi = (lane >> 4) & 1;
#pragma unroll
          for (int r = 0; r < 4; ++r) {
            float a = row_sum16(ss[r]);
            float c = row_sum16(bs[r]);
            float a0 = rdlane(a, 0) + rdlane(a, 32), a1 = rdlane(a, 16) + rdlane(a, 48);
            float c0 = rdlane(c, 0) + rdlane(c, 32), c1 = rdlane(c, 16) + rdlane(c, 48);
            ss[r] = qhi ? a1 : a0;
            bs[r] = qhi ? c1 : c0;
          }
        }
#pragma unroll
        for (int r = 0; r < 4; ++r) {
          const float inv = __builtin_amdgcn_rcpf(fmaxf(__builtin_amdgcn_sqrtf(ss[r]), 1e-12f));
          float* vt = rec + ((b * 2 + d) * 8 + qb + r) * 384;
#pragma unroll
          for (int nbi = 0; nbi < 2; ++nbi) {
            const int ch = (hi * 2 + nbi) * 16 + c16;
            const float kn = kk[nbi][r] * inv;
            vt[ch] = dec[nbi][r];
            vt[64 + ch] = -kn;
            vt[128 + ch] = kn * asg[nbi][r];
            vt[192 + ch] = kd[nbi][r];
            vt[256 + ch] = rr[nbi][r];
            vt[320 + ch] = vv[nbi][r];
          }
          if ((lane & 47) == 0) bsl[(b * 2 + d) * 8 + qb + r] = bs[r];
        }
      }
#undef LOAD_B
#undef MFMA_B
      prefetch_tile(in + 1);
    };
    prefetch_tile(0);
    prod_iter(-1, 0);
    __syncthreads();
    for (int i = 0; i <= NT; ++i) {
      prod_iter(i - 1, i + 1);
      __syncthreads();
    }
  }
  __builtin_amdgcn_s_setprio(0);
  __syncthreads();
}
DEV void phase_rwkv_scan(const int wv, const Params& p, int j, char* smem) {
  const int tid = TID;
  const int G = gridDim.x, b = BID;
  int item, step;
  if (G >= 320) { if (b < 256) { item = b; step = 1 << 20; } else { item = b; step = G - 256; } }
  else { item = b; step = G; }
  for (; item < 2304; item += step) rwkv_item(p, j, item, smem, tid);
  if (G >= 320) {
    if (b >= 256) {
      convert_wt(p.w_g + (size_t)j * DM * EI, DM, EI, p.WB, b - 256, G - 256, smem, tid);
      convert_wt(p.w_o + (size_t)j * EI * DM, EI, DM, p.WB + ((size_t)DM * EI), b - 256, G - 256, smem, tid);
    }
  } else {
    convert_wt(p.w_g + (size_t)j * DM * EI, DM, EI, p.WB, b, G, smem, tid);
    convert_wt(p.w_o + (size_t)j * EI * DM, EI, DM, p.WB + ((size_t)DM * EI), b, G, smem, tid);
  }
}

DEV void fast_barrier(unsigned* bar, const unsigned k) {
  asm volatile("s_waitcnt vmcnt(0)" ::: "memory");
  __syncthreads();
  if (threadIdx.x == 0) {
    __builtin_amdgcn_fence(__ATOMIC_RELEASE, "agent");
    asm volatile("s_waitcnt vmcnt(0)" ::: "memory");
    const unsigned G = gridDim.x;
    const unsigned g = blockIdx.x & 15u;
    const unsigned ng = (G - g + 15u) >> 4;
    const unsigned ngroups = G < 16u ? G : 16u;
    unsigned* grp_cnt = bar + 64 * g;
    unsigned* grp_gen = bar + 64 * (16 + g);
    unsigned* top_cnt = bar + 64 * 32;
    const unsigned old = __hip_atomic_fetch_add(grp_cnt, 1u, __ATOMIC_RELAXED, __HIP_MEMORY_SCOPE_AGENT);
    if (old + 1u == k * ng) {
      const unsigned oldt = __hip_atomic_fetch_add(top_cnt, 1u, __ATOMIC_RELAXED, __HIP_MEMORY_SCOPE_AGENT);
      if (oldt + 1u == k * ngroups) {
        for (unsigned gg = 0; gg < ngroups; ++gg) __hip_atomic_store(bar + 64 * (16 + gg), k, __ATOMIC_RELAXED, __HIP_MEMORY_SCOPE_AGENT);
      }
    }
    unsigned sp = 0;
    while (__hip_atomic_load(grp_gen, __ATOMIC_RELAXED, __HIP_MEMORY_SCOPE_AGENT) < k) {
      __builtin_amdgcn_s_sleep(1);
      if (++sp > (1u << 24)) break;
    }
    __builtin_amdgcn_fence(__ATOMIC_ACQUIRE, "agent");
    asm volatile("s_waitcnt vmcnt(0)" ::: "memory");
  }
  __syncthreads();
}

__global__ void __launch_bounds__(256, 2) mega_kernel(Params p) {
  __shared__ __attribute__((aligned(16))) char smem[69632];
  cg::grid_group grid = cg::this_grid();
  unsigned nbar = 0;
  const int wv = __builtin_amdgcn_readfirstlane((int)(threadIdx.x >> 6));
  phase_prep(wv, p, smem);
  grid.sync();
#pragma unroll 1
  for (int layer = 0; layer < 4; ++layer) {
    phase_row(wv, p, layer, smem);
    fast_barrier(p.BAR, ++nbar);
    const int j = layer >> 1;
    if ((layer & 1) == 0) {
      phase_lru_in(wv, p, j, smem);
      fast_barrier(p.BAR, ++nbar);
      phase_conv(wv, p, j, smem);
      fast_barrier(p.BAR, ++nbar);
      phase_lru_scan(wv, p, j, smem);
      fast_barrier(p.BAR, ++nbar);
      phase_out_proj(wv, p, p.BA, p.WB + ((size_t)DM * EI), (float*)p.BC, smem);
      fast_barrier(p.BAR, ++nbar);
    } else {
      phase_mix(wv, p, j);
      fast_barrier(p.BAR, ++nbar);
      phase_rwkv_ga(wv, p, j, smem);
      fast_barrier(p.BAR, ++nbar);
      if (j == 1) { phase_rwkv_gb(wv, p, smem); fast_barrier(p.BAR, ++nbar); }
      phase_rwkv_gc(wv, p, j, smem);
      fast_barrier(p.BAR, ++nbar);
      phase_rwkv_scan(wv, p, j, smem);
      fast_barrier(p.BAR, ++nbar);
      phase_rwkv_gz(wv, p, j, smem);
      fast_barrier(p.BAR, ++nbar);
      phase_out_proj(wv, p, p.BA, p.WB + ((size_t)DM * EI), (float*)p.BB, smem);
      fast_barrier(p.BAR, ++nbar);
    }
  }
  phase_row(wv, p, 4, smem);
}

extern "C" void kernel_launch(void* const* d_in, const int* in_sizes, int n_in, void* d_out, int out_size, void* d_ws, size_t ws_size,
                              hipStream_t stream) {
  static int grid_blocks = 0;
  if (!grid_blocks) {
    int dev = 0, cus = 0, per_cu = 0;
    hipGetDevice(&dev);
    hipDeviceGetAttribute(&cus, hipDeviceAttributeMultiprocessorCount, dev);
    hipOccupancyMaxActiveBlocksPerMultiprocessor(&per_cu, (const void*)mega_kernel, 256, 0);
    if (per_cu > 2) per_cu = 2;
    if (per_cu < 1) per_cu = 1;
    grid_blocks = cus * per_cu;
  }
  Params p{};
  const float* const* in = (const float* const*)d_in;
  p.x_prompt = in[0]; p.x_sample = in[1]; p.state_lru = in[2]; p.state_rwkv = in[3]; p.c = in[4]; p.c_ctx = in[5];
  p.ada_w = in[6]; p.ada_b = in[7]; p.norm_pre = in[8]; p.norm_post = in[9];
  p.lru_w_in = in[10]; p.lru_conv_w = in[11]; p.lru_conv_b = in[12]; p.lru_gate_w = in[13]; p.lru_gate_b = in[14];
  p.lru_lambda = in[15]; p.lru_w_out = in[16];
  p.mu = in[17]; p.w_r = in[18]; p.w_k = in[19]; p.w_v = in[20]; p.w_g = in[21]; p.w_o = in[22];
  p.w0 = in[23]; p.w1 = in[24]; p.w2 = in[25]; p.a0 = in[26]; p.a1 = in[27]; p.a2 = in[28];
  p.k_k = in[29]; p.k_a = in[30]; p.r_k = in[31]; p.ln_w = in[32]; p.ln_b = in[33]; p.v0 = in[34]; p.v1 = in[35]; p.v2 = in[36];
  p.out = (float*)d_out;
  char* ws = (char*)d_ws;
  size_t off = 0;
  auto take = [&](size_t bytes) { char* r = ws + off; off += (bytes + 255) & ~(size_t)255; return r; };
  p.MOD = (float*)take(4 * 5 * 6144 * 4);
  p.W2T = (bf16_t*)take((size_t)4 * 4096 * 128 * 2);
  p.A2T = (bf16_t*)take((size_t)4 * 4096 * 128 * 2);
  p.H = (bf16_t*)take((size_t)TTOK * DM * 2);
  p.BA = (bf16_t*)take((size_t)TTOK * EI * 2);
  p.BB = (bf16_t*)take((size_t)TTOK * EI * 2);
  p.BC = (bf16_t*)take((size_t)TTOK * EI * 2);
  p.VF = (bf16_t*)take((size_t)TTOK * EI * 2);
  p.LORA1 = (bf16_t*)take((size_t)TTOK * 640 * 2);
  p.BS = (float*)take((size_t)2 * TTOK * 64 * 4);
  p.WB = (bf16_t*)take((size_t)3 * DM * EI * 2);
  p.BAR = (unsigned*)take(16384);
  if (off > ws_size) { fprintf(stderr, "workspace too small: need %zu have %zu\n", off, ws_size); return; }
  hipMemsetAsync(p.BAR, 0, 16384, stream);
  void* args[] = {&p};
  hipError_t e = hipLaunchCooperativeKernel((const void*)mega_kernel, dim3(grid_blocks), dim3(256), args, 0, stream);
  if (e != hipSuccess) fprintf(stderr, "cooperative launch failed: %s (grid %d)\n", hipGetErrorString(e), grid_blocks);
}
```

```cpp
#include <hip/hip_runtime.h>
#include <hip/hip_cooperative_groups.h>
#include <stdint.h>
#include <stdio.h>
namespace cg = cooperative_groups;

#define DEV __device__ __forceinline__

typedef unsigned short bf16_t;
using bf16x8 = __attribute__((ext_vector_type(8))) short;
using f32x4 = __attribute__((ext_vector_type(4))) float;

static constexpr int DM = 2048;
static constexpr int EI = 4096;
static constexpr int TCTX = 8192;
static constexpr int TTOK = 24576;
static constexpr size_t OFF_LRU = 50331648ull;
static constexpr size_t OFF_RWKV = 50855936ull;

struct Params {
  const float *x_prompt, *x_sample, *state_lru, *state_rwkv, *c, *c_ctx, *ada_w, *ada_b, *norm_pre, *norm_post;
  const float *lru_w_in, *lru_conv_w, *lru_conv_b, *lru_gate_w, *lru_gate_b, *lru_lambda, *lru_w_out;
  const float *mu, *w_r, *w_k, *w_v, *w_g, *w_o, *w0, *w1, *w2, *a0, *a1, *a2, *k_k, *k_a, *r_k, *ln_w, *ln_b, *v0, *v1, *v2;
  float* out;
  float* MOD;
  bf16_t* WB;
  bf16_t* W2T;
  bf16_t* A2T;
  bf16_t* H;
  bf16_t* BA;
  bf16_t* BB;
  bf16_t* BC;
  bf16_t* VF;
  bf16_t* LORA1;
  float* BS;
  unsigned* BAR;
};

DEV bf16_t f2bf(float f) {
  uint32_t u = __float_as_uint(f);
  u += 0x7fffu + ((u >> 16) & 1u);
  return (bf16_t)(u >> 16);
}
DEV float bf2f(bf16_t h) { return __uint_as_float(((uint32_t)h) << 16); }
DEV float bfs(short h) { return __uint_as_float(((uint32_t)(unsigned short)h) << 16); }
DEV float rcpf_(float x) { return __builtin_amdgcn_rcpf(x); }
DEV float sigmoidf_(float x) { return rcpf_(1.f + __expf(-x)); }
DEV float siluf_(float x) { return x * rcpf_(1.f + __expf(-x)); }
DEV float wave_sum(float v) {
#pragma unroll
  for (int o = 32; o > 0; o >>= 1) v += __shfl_xor(v, o, 64);
  return v;
}
typedef __bf16 bf2_t __attribute__((ext_vector_type(2)));
typedef float fl2_t __attribute__((ext_vector_type(2)));
DEV uint32_t pack2bf(float a, float b) {
  fl2_t v = {a, b};
  bf2_t r = __builtin_convertvector(v, bf2_t);
  return *(uint32_t*)&r;
}
DEV bf16x8 pack8bf(float a0, float a1, float a2, float a3, float a4, float a5, float a6, float a7) {
  union { uint32_t u[4]; bf16x8 v; } x;
  x.u[0] = pack2bf(a0, a1); x.u[1] = pack2bf(a2, a3); x.u[2] = pack2bf(a4, a5); x.u[3] = pack2bf(a6, a7);
  return x.v;
}
DEV int opq(int v) { asm volatile("" : "+v"(v)); return v; }
DEV int opqs(int v) { asm volatile("" : "+s"(v)); return v; }
DEV int lane_id_() { return (int)__builtin_amdgcn_mbcnt_hi(~0u, __builtin_amdgcn_mbcnt_lo(~0u, 0u)); }
#define TID opq(wv * 64 + lane_id_())
#define BID opqs((int)blockIdx.x)
template <int CTRL>
DEV float dpp_f(float x) {
  int xi = __builtin_bit_cast(int, x);
  return __builtin_bit_cast(float, __builtin_amdgcn_update_dpp(xi, xi, CTRL, 0xf, 0xf, true));
}
DEV float row_sum16(float x) {
  x += dpp_f<0xB1>(x);
  x += dpp_f<0x4E>(x);
  x += dpp_f<0x124>(x);
  x += dpp_f<0x128>(x);
  return x;
}
DEV float rdlane(float x, int l) { return __builtin_bit_cast(float, __builtin_amdgcn_readlane(__builtin_bit_cast(int, x), l)); }
DEV float wave_sum_fast(float x) {
  x = row_sum16(x);
  return (rdlane(x, 0) + rdlane(x, 16)) + (rdlane(x, 32) + rdlane(x, 48));
}
DEV void store4bf(bf16_t* p, f32x4 v) {
  uint2 u;
  u.x = pack2bf(v[0], v[1]);
  u.y = pack2bf(v[2], v[3]);
  *(uint2*)p = u;
}
DEV f32x4 load4bf(const bf16_t* p) {
  uint2 u = *(const uint2*)p;
  f32x4 v;
  v[0] = __uint_as_float(u.x << 16);
  v[1] = __uint_as_float(u.x & 0xffff0000u);
  v[2] = __uint_as_float(u.y << 16);
  v[3] = __uint_as_float(u.y & 0xffff0000u);
  return v;
}

DEV void transpose_tile(const float* __restrict__ in, int ldin, bf16_t* __restrict__ out, int ldout, int r0, int c0, char* smem, int tid) {
  float (*t)[65] = (float (*)[65])smem;
  float4 v[4];
#pragma unroll
  for (int i = 0; i < 4; ++i) {
    int idx = tid + 256 * i;
    int r = idx >> 4, c4 = (idx & 15) * 4;
    v[i] = *(const float4*)(in + (size_t)(r0 + r) * ldin + c0 + c4);
  }
#pragma unroll
  for (int i = 0; i < 4; ++i) {
    int idx = tid + 256 * i;
    int r = idx >> 4, c4 = (idx & 15) * 4;
    t[r][c4] = v[i].x; t[r][c4 + 1] = v[i].y; t[r][c4 + 2] = v[i].z; t[r][c4 + 3] = v[i].w;
  }
  __syncthreads();
  uint32_t o[8];
#pragma unroll
  for (int i = 0; i < 8; ++i) {
    int idx = tid + 256 * i;
    int cc = idx >> 5, rp = idx & 31;
    o[i] = pack2bf(t[2 * rp][cc], t[2 * rp + 1][cc]);
  }
#pragma unroll
  for (int i = 0; i < 8; ++i) {
    int idx = tid + 256 * i;
    int cc = idx >> 5, rp = idx & 31;
    *(uint32_t*)(out + (size_t)(c0 + cc) * ldout + r0 + 2 * rp) = o[i];
  }
  __syncthreads();
}

DEV void transpose_tiles4(const float* const (&in)[4], const size_t (&rc)[4], int ldin, bf16_t* const (&out)[4], const size_t (&oc)[4], int ldout,
                          int nvalid, char* smem, int tid) {
  float (*t)[64][65] = (float (*)[64][65])smem;
  float4 v[4][4];
#pragma unroll
  for (int q = 0; q < 4; ++q)
    if (q < nvalid) {
#pragma unroll
      for (int i = 0; i < 4; ++i) {
        int idx = tid + 256 * i;
        int r = idx >> 4, c4 = (idx & 15) * 4;
        v[q][i] = *(const float4*)(in[q] + rc[q] + (size_t)r * ldin + c4);
      }
    }
#pragma unroll
  for (int q = 0; q < 4; ++q)
    if (q < nvalid) {
#pragma unroll
      for (int i = 0; i < 4; ++i) {
        int idx = tid + 256 * i;
        int r = idx >> 4, c4 = (idx & 15) * 4;
        t[q][r][c4] = v[q][i].x; t[q][r][c4 + 1] = v[q][i].y; t[q][r][c4 + 2] = v[q][i].z; t[q][r][c4 + 3] = v[q][i].w;
      }
    }
  __syncthreads();
#pragma unroll
  for (int q = 0; q < 4; ++q)
    if (q < nvalid) {
#pragma unroll
      for (int i = 0; i < 8; ++i) {
        int idx = tid + 256 * i;
        int cc = idx >> 5, rp = idx & 31;
        *(uint32_t*)(out[q] + oc[q] + (size_t)cc * ldout + 2 * rp) = pack2bf(t[q][2 * rp][cc], t[q][2 * rp + 1][cc]);
      }
    }
  __syncthreads();
}

DEV void convert_wt(const float* W, int K, int N, bf16_t* WT, int worker, int nworkers, char* smem, int tid);
DEV void phase_prep(const int wv, const Params& p, char* smem) {
  float* sc = (float*)smem;
  float* red = sc + 5 * 2048;
  const int tid = TID, bid = BID;
  for (int i = tid; i < 5 * 2048; i += 256) {
    int c = i >> 11, k = i & 2047;
    float v = (c == 0) ? p.c_ctx[k] : p.c[(c - 1) * 2048 + k];
    sc[i] = siluf_(v);
  }
  __syncthreads();
  int cq = tid & 7, kl = tid >> 3;
  for (int item = bid; item < 768; item += gridDim.x) {
    int l = item / 192, cgp = item % 192;
    int c0 = cgp * 32;
    const float* W = p.ada_w + (size_t)l * 2048 * 6144 + c0 + cq * 4;
    float acc[5][4];
#pragma unroll
    for (int c = 0; c < 5; ++c)
#pragma unroll
      for (int q = 0; q < 4; ++q) acc[c][q] = 0.f;
#pragma unroll 4
    for (int k = kl; k < 2048; k += 32) {
      float4 w4 = *(const float4*)(W + (size_t)k * 6144);
#pragma unroll
      for (int c = 0; c < 5; ++c) {
        float s = sc[c * 2048 + k];
        acc[c][0] += s * w4.x; acc[c][1] += s * w4.y; acc[c][2] += s * w4.z; acc[c][3] += s * w4.w;
      }
    }
    float* r = red + (kl * 8 + cq) * 20;
#pragma unroll
    for (int c = 0; c < 5; ++c)
#pragma unroll
      for (int q = 0; q < 4; ++q) r[c * 4 + q] = acc[c][q];
    __syncthreads();
    if (tid < 160) {
      int c = tid >> 5, col = tid & 31;
      float s = 0.f;
      for (int kk = 0; kk < 32; ++kk) s += red[(kk * 8 + (col >> 2)) * 20 + c * 4 + (col & 3)];
      p.MOD[(size_t)(l * 5 + c) * 6144 + c0 + col] = s + p.ada_b[l * 6144 + c0 + col];
    }
    __syncthreads();
  }
  for (int item = bid; item < 1024; item += gridDim.x) {
    int which = item >> 9;
    int rem = item & 511;
    int mat = rem >> 7, tl = rem & 127;
    const float* src = (which == 0 ? p.w2 : p.a2) + (size_t)mat * 128 * 4096;
    bf16_t* dst = (which == 0 ? p.W2T : p.A2T) + (size_t)mat * 4096 * 128;
    transpose_tile(src, 4096, dst, 128, (tl & 1) * 64, (tl >> 1) * 64, smem, tid);
  }
}

DEV void phase_row(const int wv, const Params& p, int layer, char* smem) {
  const int tid = TID, bid = BID;
  int lane = tid & 63, w = tid >> 6;
  for (int g = bid * 4 + w; g < TTOK; g += gridDim.x * 4) {
    int c = g < TCTX ? 0 : 1 + ((g - TCTX) >> 12);
    const float* xin;
    if (layer <= 1) xin = g < TCTX ? p.x_prompt + (size_t)g * DM : p.x_sample + (size_t)(g - TCTX) * DM;
    else xin = p.out + (size_t)g * DM;
    float4 x[8];
#pragma unroll
    for (int q = 0; q < 8; ++q) x[q] = ((const float4*)xin)[q * 64 + lane];
    if (layer > 0) {
      const float* M = (const float*)(((layer - 1) & 1) == 0 ? p.BC : p.BB) + (size_t)g * DM;
      float4 m[8];
      float ss = 0.f;
#pragma unroll
      for (int q = 0; q < 8; ++q) {
        m[q] = ((const float4*)M)[q * 64 + lane];
        ss += m[q].x * m[q].x + m[q].y * m[q].y + m[q].z * m[q].z + m[q].w * m[q].w;
      }
      ss = wave_sum_fast(ss);
      float rs = __builtin_amdgcn_rsqf(ss * (1.f / 2048.f) + 1e-6f);
      const float4* gate = (const float4*)(p.MOD + (size_t)((layer - 1) * 5 + c) * 6144 + 4096);
      const float4* np = (const float4*)(p.norm_post + (layer - 1) * DM);
#pragma unroll
      for (int q = 0; q < 8; ++q) {
        float4 gt = gate[q * 64 + lane], nn = np[q * 64 + lane];
        x[q].x += gt.x * (m[q].x * rs * nn.x);
        x[q].y += gt.y * (m[q].y * rs * nn.y);
        x[q].z += gt.z * (m[q].z * rs * nn.z);
        x[q].w += gt.w * (m[q].w * rs * nn.w);
        ((float4*)(p.out + (size_t)g * DM))[q * 64 + lane] = x[q];
      }
    }
    if (layer < 4) {
      float ss = 0.f;
#pragma unroll
      for (int q = 0; q < 8; ++q) ss += x[q].x * x[q].x + x[q].y * x[q].y + x[q].z * x[q].z + x[q].w * x[q].w;
      ss = wave_sum_fast(ss);
      float rs = __builtin_amdgcn_rsqf(ss * (1.f / 2048.f) + 1e-6f);
      const float4* sh = (const float4*)(p.MOD + (size_t)(layer * 5 + c) * 6144);
      const float4* scl = (const float4*)(p.MOD + (size_t)(layer * 5 + c) * 6144 + 2048);
      const float4* np = (const float4*)(p.norm_pre + layer * DM);
#pragma unroll
      for (int q = 0; q < 8; ++q) {
        float4 s1 = sh[q * 64 + lane], s2 = scl[q * 64 + lane], nn = np[q * 64 + lane];
        f32x4 h;
        h[0] = x[q].x * rs * nn.x * (1.f + s2.x) + s1.x;
        h[1] = x[q].y * rs * nn.y * (1.f + s2.y) + s1.y;
        h[2] = x[q].z * rs * nn.z * (1.f + s2.z) + s1.z;
        h[3] = x[q].w * rs * nn.w * (1.f + s2.w) + s1.w;
        store4bf(p.H + (size_t)g * DM + (q * 64 + lane) * 4, h);
      }
    }
  }
  if (layer < 4) {
    const int j = layer >> 1;
    const int G = gridDim.x;
    if ((layer & 1) == 0) {
      for (int it0 = bid; it0 < 1024; it0 += 4 * G) {
        const float* in[4]; bf16_t* out[4]; size_t rc[4], oc[4];
        int nvalid = 0;
#pragma unroll
        for (int q = 0; q < 4; ++q) {
          const int item = it0 + q * G;
          const int ic = item < 1024 ? item : it0;
          const int mat = ic >> 4, tl = ic & 15;
          in[q] = p.lru_gate_w + (size_t)(j * 64 + mat) * 65536;
          out[q] = p.WB + (size_t)mat * 65536;
          rc[q] = (size_t)((tl >> 2) * 64) * 256 + (tl & 3) * 64;
          oc[q] = (size_t)((tl & 3) * 64) * 256 + (tl >> 2) * 64;
          nvalid += (item < 1024) ? 1 : 0;
        }
        transpose_tiles4(in, rc, 256, out, oc, 256, nvalid, smem, tid);
      }
      convert_wt(p.lru_w_in + (size_t)j * DM * 8192, DM, 8192, p.WB + ((size_t)DM * EI), bid, G, smem, tid);
    } else {
      convert_wt(p.w_v + (size_t)j * DM * EI, DM, EI, p.WB, bid, G, smem, tid);
      convert_wt(p.w_r + (size_t)j * DM * EI, DM, EI, p.WB + ((size_t)DM * EI), bid, G, smem, tid);
      convert_wt(p.w_k + (size_t)j * DM * EI, DM, EI, p.WB + 2 * ((size_t)DM * EI), bid, G, smem, tid);
    }
  }
}

struct ALPlain {
  const bf16_t* p;
  int ld;
  struct Raw { bf16x8 v; };
  DEV void prep(int k) {}
  DEV void fetch(int row, int k, Raw& r) const { r.v = *(const bf16x8*)(p + (size_t)row * ld + k); }
  DEV bf16x8 finish(const Raw& r) const { return r.v; }
};
struct EpBF16 {
  bf16_t* C; int ldc;
  DEV void operator()(int m, int n, f32x4 v) const { store4bf(C + (size_t)m * ldc + n, v); }
};
struct EpXZ {
  bf16_t* X; bf16_t* Z;
  DEV void operator()(int m, int n, f32x4 v) const {
    if (n < EI) store4bf(X + (size_t)m * EI + n, v);
    else {
      f32x4 s;
#pragma unroll
      for (int i = 0; i < 4; ++i) s[i] = siluf_(v[i]);
      store4bf(Z + (size_t)m * EI + (n - EI), s);
    }
  }
};
struct EpF32 {
  float* C; int ldc;
  DEV void operator()(int m, int n, f32x4 v) const { *(f32x4*)(C + (size_t)m * ldc + n) = v; }
};
struct EpLora {
  bf16_t* C; int do_tanh;
  DEV void operator()(int m, int n, f32x4 v) const {
    if (do_tanh) {
#pragma unroll
      for (int i = 0; i < 4; ++i) { float xc = fminf(fmaxf(v[i], -15.f), 15.f); v[i] = 1.f - 2.f * rcpf_(1.f + __expf(2.f * xc)); }
    }
    store4bf(C + (size_t)m * 640 + n, v);
  }
};
struct EpVmix {
  bf16_t* C; const float* v0;
  DEV void operator()(int m, int n, f32x4 v) const {
    f32x4 b = *(const f32x4*)(v0 + n);
#pragma unroll
    for (int i = 0; i < 4; ++i) v[i] = sigmoidf_(v[i] + b[i]);
    store4bf(C + (size_t)m * EI + n, v);
  }
};
struct EpVmixV {
  bf16_t* VFp; const bf16_t* MIX;
  DEV void operator()(int m, int n, f32x4 v) const {
    f32x4 vf = load4bf(VFp + (size_t)m * EI + n);
    f32x4 mx = load4bf(MIX + (size_t)m * EI + n);
#pragma unroll
    for (int i = 0; i < 4; ++i) v[i] = v[i] + (vf[i] - v[i]) * mx[i];
    store4bf(VFp + (size_t)m * EI + n, v);
  }
};
struct EpZ {
  bf16_t* Y;
  DEV void operator()(int m, int n, f32x4 v) const {
    f32x4 y = load4bf(Y + (size_t)m * EI + n);
#pragma unroll
    for (int i = 0; i < 4; ++i) y[i] = y[i] * siluf_(v[i]);
    store4bf(Y + (size_t)m * EI + n, y);
  }
};

template <bool CHK, class AL, class EP>
DEV void gemm_tile(AL al, const float* __restrict__ Bp, int ldb, int Kv, int Nv, int K, int m0, int n0, const EP& ep, char* smem, const int tid) {
  bf16_t (*As)[80] = (bf16_t (*)[80])smem;
  bf16_t (*Bs)[80] = (bf16_t (*)[80])(smem + 128 * 80 * 2);
  const int lane = tid & 63, w = tid >> 6, wm = w >> 1, wn = w & 1;
  f32x4 acc[4][4];
#pragma unroll
  for (int i = 0; i < 4; ++i)
#pragma unroll
    for (int j = 0; j < 4; ++j) acc[i][j] = f32x4{0.f, 0.f, 0.f, 0.f};
  typename AL::Raw ra[4];
  float4 rb[8];
  const int arow = tid >> 3, akc = (tid & 7) * 8;
  const int bkg = tid >> 5, bnq = tid & 31;
  const int nk = K >> 6;
  const int bn = n0 + bnq * 4;

  const bool nok = bn < Nv;
  const int bnc = nok ? bn : 0;
  auto fetch = [&](int kt) {
#pragma unroll
    for (int i = 0; i < 4; ++i) al.fetch(m0 + arow + 32 * i, kt * 64 + akc, ra[i]);
    const int k0 = kt * 64 + bkg * 8;
    const bool ok = CHK ? (nok && (k0 < Kv)) : true;
    const float* bp = Bp + (size_t)(ok ? k0 : 0) * ldb + bnc;
#pragma unroll
    for (int i = 0; i < 8; ++i) {
      float4 v = *(const float4*)bp;
      bp += ldb;
      rb[i] = ok ? v : float4{0.f, 0.f, 0.f, 0.f};
    }
  };
  fetch(0);
  for (int kt = 0; kt < nk; ++kt) {
    al.prep(kt * 64 + akc);
#pragma unroll
    for (int i = 0; i < 4; ++i) *(bf16x8*)&As[arow + 32 * i][akc] = al.finish(ra[i]);
    {
      bf16x8 v0 = pack8bf(rb[0].x, rb[1].x, rb[2].x, rb[3].x, rb[4].x, rb[5].x, rb[6].x, rb[7].x);
      bf16x8 v1 = pack8bf(rb[0].y, rb[1].y, rb[2].y, rb[3].y, rb[4].y, rb[5].y, rb[6].y, rb[7].y);
      bf16x8 v2 = pack8bf(rb[0].z, rb[1].z, rb[2].z, rb[3].z, rb[4].z, rb[5].z, rb[6].z, rb[7].z);
      bf16x8 v3 = pack8bf(rb[0].w, rb[1].w, rb[2].w, rb[3].w, rb[4].w, rb[5].w, rb[6].w, rb[7].w);
      *(bf16x8*)&Bs[bnq * 4 + 0][bkg * 8] = v0;
      *(bf16x8*)&Bs[bnq * 4 + 1][bkg * 8] = v1;
      *(bf16x8*)&Bs[bnq * 4 + 2][bkg * 8] = v2;
      *(bf16x8*)&Bs[bnq * 4 + 3][bkg * 8] = v3;
    }
    __syncthreads();
    if (kt + 1 < nk) fetch(kt + 1);
#pragma unroll
    for (int ks = 0; ks < 2; ++ks) {
      bf16x8 af[4], bfr[4];
#pragma unroll
      for (int i = 0; i < 4; ++i) af[i] = *(const bf16x8*)&As[wm * 64 + i * 16 + (lane & 15)][ks * 32 + (lane >> 4) * 8];
#pragma unroll
      for (int j = 0; j < 4; ++j) bfr[j] = *(const bf16x8*)&Bs[wn * 64 + j * 16 + (lane & 15)][ks * 32 + (lane >> 4) * 8];
#pragma unroll
      for (int i = 0; i < 4; ++i)
#pragma unroll
        for (int j = 0; j < 4; ++j) acc[i][j] = __builtin_amdgcn_mfma_f32_16x16x32_bf16(bfr[j], af[i], acc[i][j], 0, 0, 0);
    }
    __syncthreads();
  }
#pragma unroll
  for (int i = 0; i < 4; ++i)
#pragma unroll
    for (int j = 0; j < 4; ++j) ep(m0 + wm * 64 + i * 16 + (lane & 15), n0 + wn * 64 + j * 16 + (lane >> 4) * 4, acc[i][j]);
}

static constexpr int GBN = 256;
template <class EP>
DEV void gemm_tile_bt(const bf16_t* __restrict__ Ap, int lda, const bf16_t* __restrict__ Bt, int K, int m0, int n0, const EP& ep, char* smem, const int tid) {
  bf16_t (*As)[48] = (bf16_t (*)[48])smem;
  bf16_t (*Bs)[48] = (bf16_t (*)[48])(smem + 128 * 48 * 2);
  const int lane = tid & 63, w = tid >> 6, wm = w >> 1, wn = w & 1;
  f32x4 acc[4][8];
#pragma unroll
  for (int i = 0; i < 4; ++i)
#pragma unroll
    for (int j = 0; j < 8; ++j) acc[i][j] = f32x4{0.f, 0.f, 0.f, 0.f};
  bf16x8 ra0[2], rb0[4];
  const int ari = tid >> 2;
  const int arow = (ari & ~3) | ((ari & 1) << 1) | ((ari >> 1) & 1), akc = (tid & 3) * 8;
  const int nk = K >> 5;
  const bf16_t* Ag = Ap + (size_t)(m0 + arow) * lda + akc;
  const bf16_t* Bg = Bt + (size_t)(n0 + arow) * K + akc;
#define BT_FETCH(kt, ra, rb)                                                                      \
  {                                                                                                \
    _Pragma("unroll") for (int i = 0; i < 2; ++i) ra[i] = *(const bf16x8*)(Ag + (size_t)(64 * i) * lda + (kt) * 32); \
    _Pragma("unroll") for (int i = 0; i < 4; ++i) rb[i] = *(const bf16x8*)(Bg + (size_t)(64 * i) * K + (kt) * 32);   \
  }
#define BT_STEP(kt, ra, rb)                                                                        \
  {                                                                                                \
    _Pragma("unroll") for (int i = 0; i < 2; ++i) *(bf16x8*)&As[arow + 64 * i][akc] = ra[i];      \
    _Pragma("unroll") for (int i = 0; i < 4; ++i) *(bf16x8*)&Bs[arow + 64 * i][akc] = rb[i];      \
    __syncthreads();                                                                               \
    if ((kt) + 1 < nk) BT_FETCH((kt) + 1, ra, rb)                                                  \
    {                                                                                              \
      bf16x8 af[4];                                                                                \
      _Pragma("unroll") for (int i = 0; i < 4; ++i) af[i] = *(const bf16x8*)&As[wm * 64 + i * 16 + (lane & 15)][(lane >> 4) * 8];  \
      _Pragma("unroll") for (int jh = 0; jh < 2; ++jh) {                                           \
        bf16x8 bfr[4];                                                                             \
        _Pragma("unroll") for (int j = 0; j < 4; ++j) bfr[j] = *(const bf16x8*)&Bs[wn * 128 + (jh * 4 + j) * 16 + (lane & 15)][(lane >> 4) * 8]; \
        _Pragma("unroll") for (int i = 0; i < 4; ++i)                                              \
          _Pragma("unroll") for (int j = 0; j < 4; ++j) acc[i][jh * 4 + j] = __builtin_amdgcn_mfma_f32_16x16x32_bf16(bfr[j], af[i], acc[i][jh * 4 + j], 0, 0, 0); \
        __builtin_amdgcn_sched_barrier(0);                                                         \
      }                                                                                            \
    }                                                                                              \
    __syncthreads();                                                                               \
  }
  BT_FETCH(0, ra0, rb0)
  for (int kt = 0; kt < nk; ++kt) {
    BT_STEP(kt, ra0, rb0)
  }
#undef BT_FETCH
#undef BT_STEP
#pragma unroll
  for (int i = 0; i < 4; ++i)
#pragma unroll
    for (int j = 0; j < 8; ++j) ep(m0 + wm * 64 + i * 16 + (lane & 15), n0 + wn * 128 + j * 16 + (lane >> 4) * 4, acc[i][j]);
}

DEV void convert_wt(const float* W, int K, int N, bf16_t* WT, int worker, int nworkers, char* smem, int tid) {
  const int nt_n = N >> 6;
  const int total = (K >> 6) * nt_n;
  for (int t0 = worker; t0 < total; t0 += 4 * nworkers) {
    const float* in[4] = {W, W, W, W};
    bf16_t* out[4] = {WT, WT, WT, WT};
    size_t rc[4], oc[4];
    int nvalid = 0;
#pragma unroll
    for (int q = 0; q < 4; ++q) {
      const int t = t0 + q * nworkers;
      const int tc = t < total ? t : t0;
      const int kt = tc / nt_n, nt = tc % nt_n;
      rc[q] = (size_t)(kt * 64) * N + nt * 64;
      oc[q] = (size_t)(nt * 64) * K + kt * 64;
      nvalid += (t < total) ? 1 : 0;
    }
    transpose_tiles4(in, rc, N, out, oc, K, nvalid, smem, tid);
  }
}

DEV void tile_map(int t, int lognt, int& mt, int& nt) {
  if (gridDim.x == 512) {
    const int r = t >> 9, b = t & 511;
    const int xcd = b & 7, slot = b >> 3;
    const int logpc = lognt - 3;
    const int pc = xcd & ((1 << logpc) - 1), pr = xcd >> logpc;
    mt = r * (64 >> logpc) + pr * 8 + (slot >> 3);
    nt = pc * 8 + (slot & 7);
  } else {
    nt = t & ((1 << lognt) - 1);
    mt = t >> lognt;
  }
}
static constexpr int MT = TTOK / 128;

DEV void phase_lru_in(const int wv, const Params& p, int j, char* smem) {
  const int tid = TID, bid = BID;
  EpXZ ep{p.BA, p.BB};
  const bf16_t* Bt = p.WB + ((size_t)DM * EI);
  for (int t = bid; t < MT * 32; t += gridDim.x) {
    int nt, mt; tile_map(t, 5, mt, nt); mt = (TTOK / 128 - 1) - mt;
    gemm_tile_bt(p.H, DM, Bt, DM, mt * 128, nt * GBN, ep, smem, tid);
  }
}
DEV void phase_out_proj(const int wv, const Params& p, const bf16_t* A, const bf16_t* Wt, float* Mout, char* smem) {
  const int tid = TID, bid = BID;
  EpF32 ep{Mout, DM};
  for (int t = bid; t < MT * 8; t += gridDim.x) {
    int nt, mt; tile_map(t, 3, mt, nt); mt = (TTOK / 128 - 1) - mt;
    gemm_tile_bt(A, EI, Wt, EI, mt * 128, nt * GBN, ep, smem, tid);
  }
}
DEV void phase_conv(const int wv, const Params& p, int j, char* smem) {
  const bf16_t* XB = p.BA;
  bf16_t* XC = p.BC;
  const float* cw = p.lru_conv_w + (size_t)j * 4 * EI;
  const float* cb = p.lru_conv_b + (size_t)j * EI;
  const int total = TTOK * 512;
  const int tid = TID, bid = BID;
  for (int idx = bid * 256 + tid; idx < total; idx += gridDim.x * 256) {
    int g = idx >> 9, e = (idx & 511) * 8;
    int t, L;
    if (g < TCTX) { t = g & 255; L = 256; } else { t = (g - TCTX) & 4095; L = 4096; }
    float acc[8];
    {
      float4 b0 = *(const float4*)(cb + e), b1 = *(const float4*)(cb + e + 4);
      acc[0] = b0.x; acc[1] = b0.y; acc[2] = b0.z; acc[3] = b0.w; acc[4] = b1.x; acc[5] = b1.y; acc[6] = b1.z; acc[7] = b1.w;
    }
#pragma unroll
    for (int tap = 0; tap < 4; ++tap) {
      int tt = t + tap - 2;
      if (tt >= 0 && tt < L) {
        bf16x8 xv = *(const bf16x8*)(XB + (size_t)(g + tap - 2) * EI + e);
        float4 w0 = *(const float4*)(cw + tap * EI + e), w1 = *(const float4*)(cw + tap * EI + e + 4);
        acc[0] += w0.x * bfs(xv[0]); acc[1] += w0.y * bfs(xv[1]); acc[2] += w0.z * bfs(xv[2]); acc[3] += w0.w * bfs(xv[3]);
        acc[4] += w1.x * bfs(xv[4]); acc[5] += w1.y * bfs(xv[5]); acc[6] += w1.z * bfs(xv[6]); acc[7] += w1.w * bfs(xv[7]);
      }
    }
    *(bf16x8*)(XC + (size_t)g * EI + e) = pack8bf(acc[0], acc[1], acc[2], acc[3], acc[4], acc[5], acc[6], acc[7]);
  }
  convert_wt(p.lru_w_out + (size_t)j * EI * DM, EI, DM, p.WB + ((size_t)DM * EI), bid, gridDim.x, smem, tid);
}

DEV void lru_item(const Params& p, int j, int item, char* smem, const int tid) {
  float (*sA)[64][64] = (float (*)[64][64])smem;
  float (*sU)[64][64] = (float (*)[64][64])(smem + 32768);
  const bf16_t* XC = p.BC;
  const bf16_t* ZB = p.BB;
  bf16_t* Y = p.BA;
  const int lane = tid & 63, w = tid >> 6;
  int s, n, sl;
  if (item < 256) { s = 32 + (item >> 6); n = (item & 63) >> 2; sl = item & 3; }
  else { int i2 = item - 256; s = i2 >> 6; n = (i2 & 63) >> 2; sl = i2 & 3; }
  const int L = s < 32 ? 256 : 4096;
  const size_t g0 = s < 32 ? (size_t)s * 256 : (size_t)TCTX + (size_t)(s - 32) * 4096;
  const int NT = L >> 6;
  const int e0 = n * 256 + sl * 64;
  const int sd = tid >> 6, sch = tid & 63;
  float hst = 0.f;
  if (tid < 128 && s >= 32) hst = p.state_lru[(size_t)(((s - 32) * 2 + j) * 2 + sd) * EI + e0 + sch];
  const int ch = w * 16 + (lane & 15);
  float gbr[2], gbi[2], sp[2];
#pragma unroll
  for (int d = 0; d < 2; ++d) {
    gbr[d] = p.lru_gate_b[(size_t)((j * 2 + d) * 2 + 0) * EI + e0 + ch];
    gbi[d] = p.lru_gate_b[(size_t)((j * 2 + d) * 2 + 1) * EI + e0 + ch];
    float lam = p.lru_lambda[(size_t)(j * 2 + d) * EI + e0 + ch];
    float xx = -lam;
    { float tt = __expf(xx); float ser = tt * (1.f + tt * (-0.5f + tt * (0.33333334f + tt * (-0.25f + tt * 0.2f)))); sp[d] = xx > 20.f ? xx : (tt < 0.05f ? ser : __logf(1.f + tt)); }
  }
  for (int it = 0; it < NT; ++it) {
    const bool first = it < (NT >> 1);
    bf16x8 partv[2][2], zv[2][2];
    {
      const size_t gt0 = g0 + (size_t)it * 64, gt1 = g0 + (size_t)(NT - 1 - it) * 64;
      bf16_t (*At)[64][264] = (bf16_t (*)[64][264])smem;
      bf16x8 areg[2][8];
#pragma unroll
      for (int i = 0; i < 8; ++i) {
        const int id = tid + 256 * i;
        const int row = id >> 5, c8 = (id & 31) * 8;
        areg[0][i] = *(const bf16x8*)(XC + (gt0 + row) * EI + n * 256 + c8);
        areg[1][i] = *(const bf16x8*)(XC + (gt1 + row) * EI + n * 256 + c8);
      }
      const bf16_t* Bw0r = p.WB + ((((size_t)0 * 2 + 0) * 16 + n) * 256 + (sl * 64 + ch)) * 256 + (lane >> 4) * 8;
      const bf16_t* Bw0i = p.WB + ((((size_t)0 * 2 + 1) * 16 + n) * 256 + (sl * 64 + ch)) * 256 + (lane >> 4) * 8;
      const bf16_t* Bw1r = p.WB + ((((size_t)1 * 2 + 0) * 16 + n) * 256 + (sl * 64 + ch)) * 256 + (lane >> 4) * 8;
      const bf16_t* Bw1i = p.WB + ((((size_t)1 * 2 + 1) * 16 + n) * 256 + (sl * 64 + ch)) * 256 + (lane >> 4) * 8;
      bf16x8 brA[4], biA[4], brB[4], biB[4];
#define LRU_LOADB(BR, BI, PR, PI, half) \
  _Pragma("unroll") for (int ks = 0; ks < 4; ++ks) { BR[ks] = *(const bf16x8*)(PR + ((half) * 4 + ks) * 32); BI[ks] = *(const bf16x8*)(PI + ((half) * 4 + ks) * 32); }
#define LRU_MMA(d, half, BR, BI)                                                                                  \
  _Pragma("unroll") for (int ks = 0; ks < 4; ++ks)                                                                \
    _Pragma("unroll") for (int mb = 0; mb < 4; ++mb) {                                                            \
      const bf16x8 af = *(const bf16x8*)&At[d][mb * 16 + (lane & 15)][((half) * 4 + ks) * 32 + (lane >> 4) * 8]; \
      ar[d][mb] = __builtin_amdgcn_mfma_f32_16x16x32_bf16(af, BR[ks], ar[d][mb], 0, 0, 0);                        \
      ai[d][mb] = __builtin_amdgcn_mfma_f32_16x16x32_bf16(af, BI[ks], ai[d][mb], 0, 0, 0);                        \
    }
      LRU_LOADB(brA, biA, Bw0r, Bw0i, 0)
      LRU_LOADB(brB, biB, Bw0r, Bw0i, 1)
      __builtin_amdgcn_sched_barrier(0);
#pragma unroll
      for (int i = 0; i < 8; ++i) {
        const int id = tid + 256 * i;
        const int row = id >> 5, c8 = (id & 31) * 8;
        *(bf16x8*)&At[0][row][c8] = areg[0][i];
        *(bf16x8*)&At[1][row][c8] = areg[1][i];
      }
      __syncthreads();
      f32x4 ar[2][4], ai[2][4];
#pragma unroll
      for (int d = 0; d < 2; ++d)
#pragma unroll
        for (int mb = 0; mb < 4; ++mb) { ar[d][mb] = f32x4{0.f, 0.f, 0.f, 0.f}; ai[d][mb] = f32x4{0.f, 0.f, 0.f, 0.f}; }
      LRU_MMA(0, 0, brA, biA)
      __builtin_amdgcn_sched_barrier(0);
      LRU_LOADB(brA, biA, Bw1r, Bw1i, 0)
      LRU_MMA(0, 1, brB, biB)
      __builtin_amdgcn_sched_barrier(0);
      LRU_LOADB(brB, biB, Bw1r, Bw1i, 1)
      LRU_MMA(1, 0, brA, biA)
      __builtin_amdgcn_sched_barrier(0);
      LRU_MMA(1, 1, brB, biB)
#undef LRU_LOADB
#undef LRU_MMA
      unsigned short xfr[2][4][4];
#pragma unroll
      for (int d = 0; d < 2; ++d)
#pragma unroll
        for (int mb = 0; mb < 4; ++mb)
#pragma unroll
          for (int r = 0; r < 4; ++r) xfr[d][mb][r] = At[d][mb * 16 + (lane >> 4) * 4 + r][sl * 64 + ch];
      if (!first) {
#pragma unroll
        for (int d = 0; d < 2; ++d) {
          const size_t gt = d == 0 ? gt0 : gt1;
#pragma unroll
          for (int i = 0; i < 2; ++i) {
            int idx = tid + 256 * i;
            int tok = idx >> 3, cc = idx & 7;
            size_t g = gt + tok;
            partv[d][i] = *(const bf16x8*)(Y + g * EI + e0 + cc * 8);
            zv[d][i] = *(const bf16x8*)(ZB + g * EI + e0 + cc * 8);
          }
        }
      }
      __syncthreads();
#pragma unroll
      for (int d = 0; d < 2; ++d)
#pragma unroll
        for (int mb = 0; mb < 4; ++mb)
#pragma unroll
          for (int r = 0; r < 4; ++r) {
            int tok = mb * 16 + (lane >> 4) * 4 + r;
            float rg = sigmoidf_(ar[d][mb][r] + gbr[d]);
            float ig = sigmoidf_(ai[d][mb][r] + gbi[d]);
            float la = -8.f * rg * sp[d];
            float a = __expf(la);
            float x2 = -2.f * la;
            float poly = x2 * (1.f + x2 * (-0.5f + x2 * (0.16666667f + x2 * (-0.041666668f + x2 * (0.0083333338f + x2 * (-0.0013888889f))))));
            float om = x2 < 0.4f ? poly : 1.f - __expf(-x2);
            float u = __builtin_amdgcn_sqrtf(fmaxf(om, 0.f)) * (ig * bf2f(xfr[d][mb][r]));
            sA[d][tok][ch] = a;
            sU[d][tok][ch] = u;
          }
    }
    __syncthreads();
    if (tid < 128) {
#pragma unroll 1
      for (int c0 = 0; c0 < 64; c0 += 16) {
        float av[16], uv[16];
#pragma unroll
        for (int t = 0; t < 16; ++t) {
          const int tok = sd == 0 ? c0 + t : 63 - (c0 + t);
          av[t] = sA[sd][tok][sch];
          uv[t] = sU[sd][tok][sch];
        }
#pragma unroll
        for (int t = 0; t < 16; ++t) { hst = av[t] * hst + uv[t]; uv[t] = hst; }
#pragma unroll
        for (int t = 0; t < 16; ++t) {
          const int tok = sd == 0 ? c0 + t : 63 - (c0 + t);
          sU[sd][tok][sch] = uv[t];
        }
      }
    }
    __syncthreads();
#pragma unroll
    for (int d = 0; d < 2; ++d) {
      const int tile = d == 0 ? it : NT - 1 - it;
#pragma unroll
      for (int i = 0; i < 2; ++i) {
        int idx = tid + 256 * i;
        int tok = idx >> 3, cc = idx & 7;
        size_t g = g0 + (size_t)tile * 64 + tok;
        float4 y0 = *(const float4*)&sU[d][tok][cc * 8], y1 = *(const float4*)&sU[d][tok][cc * 8 + 4];
        float y[8] = {y0.x, y0.y, y0.z, y0.w, y1.x, y1.y, y1.z, y1.w};
        bf16_t* yp = Y + g * EI + e0 + cc * 8;
        if (first) {
          *(bf16x8*)yp = pack8bf(y[0], y[1], y[2], y[3], y[4], y[5], y[6], y[7]);
        } else {
          bf16x8 part = partv[d][i], z = zv[d][i];
          *(bf16x8*)yp = pack8bf((y[0] + bfs(part[0])) * bfs(z[0]), (y[1] + bfs(part[1])) * bfs(z[1]), (y[2] + bfs(part[2])) * bfs(z[2]),
                                 (y[3] + bfs(part[3])) * bfs(z[3]), (y[4] + bfs(part[4])) * bfs(z[4]), (y[5] + bfs(part[5])) * bfs(z[5]),
                                 (y[6] + bfs(part[6])) * bfs(z[6]), (y[7] + bfs(part[7])) * bfs(z[7]));
        }
      }
    }
    __syncthreads();
  }
  if (tid < 128 && s < 32) p.out[OFF_LRU + (size_t)((s * 2 + j) * 2 + sd) * EI + e0 + sch] = hst;
}
DEV void phase_lru_scan(const int wv, const Params& p, int j, char* smem) {
  const int tid = TID;
  const int G = gridDim.x, b = BID;
  int item, step;
  if (G >= 320) { if (b < 256) { item = b; step = 1 << 20; } else { item = b; step = G - 256; } }
  else { item = b; step = G; }
  for (; item < 2304; item += step) lru_item(p, j, item, smem, tid);
}

DEV void phase_mix(const int wv, const Params& p, int j) {
  const int tid = TID, bid = BID;
  const float* mu = p.mu + (size_t)j * 5 * DM;
  const size_t HALF = (size_t)TTOK * DM;
  bf16_t* dst[5] = {p.BA, p.BB + HALF, p.BA + HALF, p.BB, p.BC};
  for (int idx = bid * 256 + tid; idx < TTOK * 256; idx += gridDim.x * 256) {
    const int ridx = TTOK * 256 - 1 - idx;
    const int row = ridx >> 8, k = (ridx & 255) * 8;
    int srow; bool valid;
    if (row < TCTX) {
      int t = row & 255;
      if (k < 1024) { srow = row - 1; valid = t > 0; } else { srow = row + 1; valid = t < 255; }
    } else {
      int t = (row - TCTX) & 4095;
      int q = k >> 9;
      if (q == 0) { srow = row - 1; valid = (t & 63) != 0; }
      else if (q == 1) { srow = row + 1; valid = (t & 63) != 63; }
      else if (q == 2) { srow = row - 64; valid = t >= 64; }
      else { srow = row + 64; valid = t < 4096 - 64; }
    }
    bf16x8 hv = *(const bf16x8*)(p.H + (size_t)row * DM + k);
    bf16x8 sv = *(const bf16x8*)(p.H + (size_t)(valid ? srow : row) * DM + k);
    float h[8], dx[8];
#pragma unroll
    for (int i = 0; i < 8; ++i) { h[i] = bfs(hv[i]); dx[i] = valid ? bfs(sv[i]) - h[i] : -h[i]; }
#pragma unroll
    for (int m = 0; m < 5; ++m) {
      float4 m0 = *(const float4*)(mu + m * DM + k), m1 = *(const float4*)(mu + m * DM + k + 4);
      *(bf16x8*)(dst[m] + (size_t)row * DM + k) =
          pack8bf(h[0] + dx[0] * m0.x, h[1] + dx[1] * m0.y, h[2] + dx[2] * m0.z, h[3] + dx[3] * m0.w,
                  h[4] + dx[4] * m1.x, h[5] + dx[5] * m1.y, h[6] + dx[6] * m1.z, h[7] + dx[7] * m1.w);
    }
  }
}
DEV void phase_rwkv_ga(const int wv, const Params& p, int j, char* smem) {
  const int tid = TID, bid = BID;
  const size_t HALF = (size_t)TTOK * DM;
  const int T0 = (j == 0) ? MT * 16 : 0;
  const int nsmall = (j == 0) ? 4 : 5;
  const int total = T0 + MT * nsmall;
  for (int t = bid; t < total; t += gridDim.x) {
    if (t < T0) {
      int nt, mt; tile_map(t, 4, mt, nt);
      EpBF16 ep{p.VF, EI};
      gemm_tile_bt(p.BB, DM, p.WB, DM, mt * 128, nt * GBN, ep, smem, tid);
    } else {
      int loc = t - T0;
      int job = loc / MT, mt = loc % MT;
      const bf16_t* Aj; const float* Bj; int ldbj = 128, nvj = 128, tanhj = 0; bf16_t* Cj;
      if (job < 2) { Aj = p.BB + HALF; Bj = p.w1 + (size_t)(j * 2 + job) * DM * 128; Cj = p.LORA1 + job * 128; tanhj = 1; }
      else if (job < 4) { Aj = p.BC; Bj = p.a1 + (size_t)(j * 2 + (job - 2)) * DM * 128; Cj = p.LORA1 + 256 + (job - 2) * 128; }
      else { Aj = p.BB; Bj = p.v1; ldbj = 96; nvj = 96; Cj = p.LORA1 + 512; }
      ALPlain alj{Aj, DM};
      EpLora ep{Cj, tanhj};
      gemm_tile<true>(alj, Bj, ldbj, DM, nvj, DM, mt * 128, 0, ep, smem, tid);
    }
  }
}
DEV void phase_rwkv_gb(const int wv, const Params& p, char* smem) {
  const int tid = TID, bid = BID;
  ALPlain all{p.LORA1 + 512, 640};
  EpVmix ep1{p.BC, p.v0};
  EpVmixV ep2{p.VF, p.BC};
  for (int t = bid; t < MT * 16; t += gridDim.x) {
    int nt, mt; tile_map(t, 4, mt, nt); mt = (TTOK / 128 - 1) - mt;
    gemm_tile<true>(all, p.v2, EI, 96, EI, 128, mt * 128, nt * GBN, ep1, smem, tid);
    gemm_tile<true>(all, p.v2, EI, 96, EI, 128, mt * 128, nt * GBN + 128, ep1, smem, tid);
    __syncthreads();
    gemm_tile_bt(p.BB, DM, p.WB, DM, mt * 128, nt * GBN, ep2, smem, tid);
  }
}
DEV void phase_rwkv_gc(const int wv, const Params& p, int j, char* smem) {
  const int tid = TID, bid = BID;
  const size_t HALF = (size_t)TTOK * DM;
  EpBF16 epr{p.BB, EI}, epk{p.BC, EI};
  for (int t = bid; t < MT * 32; t += gridDim.x) {
    int job = t / (MT * 16), loc = t % (MT * 16);
    int nt, mt; tile_map(loc, 4, mt, nt);
    if (job == 0) gemm_tile_bt(p.BA, DM, p.WB + ((size_t)DM * EI), DM, mt * 128, nt * GBN, epr, smem, tid);
    else gemm_tile_bt(p.BA + HALF, DM, p.WB + 2 * ((size_t)DM * EI), DM, mt * 128, nt * GBN, epk, smem, tid);
  }
}
DEV void phase_rwkv_gz(const int wv, const Params& p, int j, char* smem) {
  const int tid = TID, bid = BID;
  EpZ ep{p.BA};
  for (int t = bid; t < MT * 16; t += gridDim.x) {
    int nt, mt; tile_map(t, 4, mt, nt);
    gemm_tile_bt(p.H, DM, p.WB, DM, mt * 128, nt * GBN, ep, smem, tid);
  }
}

DEV void rwkv_item(const Params& p, int j, int item, char* smem, const int tid) {
  const int lane = tid & 63, w = tid >> 6;
  const int d = w & 1;
  const bool producer = w >= 2;
  float* rec = (float*)smem;
  float* yout = rec + 12288;
  float* bsl = yout + 2048;
  const bf16_t* R = p.BB;
  const bf16_t* Kb = p.BC;
  const bf16_t* V = p.VF;
  bf16_t* Y = p.BA;
  int s, hd;
  if (item < 256) { s = 32 + (item >> 6); hd = item & 63; } else { s = (item - 256) >> 6; hd = (item - 256) & 63; }
  const int L = s < 32 ? 256 : 4096;
  const size_t g0 = s < 32 ? (size_t)s * 256 : (size_t)TCTX + (size_t)(s - 32) * 4096;
  const int NT = L >> 3;
  const int el = hd * 64 + lane;
  if (s >= 32) __builtin_amdgcn_s_setprio(3);

  if (!producer) {
    float S[64];
    if (s >= 32) {
      const float* sp = p.state_rwkv + ((size_t)((((s - 32) * 2 + j) * 2 + d) * 64 + hd)) * 4096 + lane * 64;
#pragma unroll
      for (int k = 0; k < 64; k += 4) { float4 v = *(const float4*)(sp + k); S[k] = v.x; S[k + 1] = v.y; S[k + 2] = v.z; S[k + 3] = v.w; }
    } else {
#pragma unroll
      for (int k = 0; k < 64; ++k) S[k] = 0.f;
    }
    const int l4 = (lane & 3) * 4;
#define DPP_FMAC(acc, x, sv, J) asm("v_fmac_f32_dpp %0, %1, %2 quad_perm:[" #J "," #J "," #J "," #J "] row_mask:0xf bank_mask:0xf" : "+v"(acc) : "v"(x), "v"(sv))
#define DPP_MULS(sv, x, J) asm("v_mul_f32_dpp %0, %1, %0 quad_perm:[" #J "," #J "," #J "," #J "] row_mask:0xf bank_mask:0xf" : "+v"(sv) : "v"(x))
#define UPD_E(C, k, comp, J)            \
  DPP_FMAC(S[k], C[0].comp, sa, J);     \
  DPP_FMAC(S[k], C[1].comp, vq, J);
#define UPD_Q(C, m, J)                    \
  UPD_E(C, 16 * (m) + 4 * (J) + 0, x, J)  \
  UPD_E(C, 16 * (m) + 4 * (J) + 1, y, J)  \
  UPD_E(C, 16 * (m) + 4 * (J) + 2, z, J)  \
  UPD_E(C, 16 * (m) + 4 * (J) + 3, w, J)
#define UPD_M(C, m) UPD_Q(C, m, 0) UPD_Q(C, m, 1) UPD_Q(C, m, 2) UPD_Q(C, m, 3)
#define DOT_M(acc0, acc1, V, m)                                                               \
  _Pragma("unroll") for (int cc = 0; cc < 4; ++cc) {                                          \
    acc0 += fl2_t{S[16 * (m) + 4 * cc], S[16 * (m) + 4 * cc + 1]} * fl2_t{V[cc].x, V[cc].y};  \
    acc1 += fl2_t{S[16 * (m) + 4 * cc + 2], S[16 * (m) + 4 * cc + 3]} * fl2_t{V[cc].z, V[cc].w}; \
  }
#define MUL_M(V, m)                                                                            \
  _Pragma("unroll") for (int cc = 0; cc < 4; ++cc) {                                          \
    fl2_t t0 = fl2_t{S[16 * (m) + 4 * cc], S[16 * (m) + 4 * cc + 1]} * fl2_t{V[cc].x, V[cc].y};  \
    fl2_t t1 = fl2_t{S[16 * (m) + 4 * cc + 2], S[16 * (m) + 4 * cc + 3]} * fl2_t{V[cc].z, V[cc].w}; \
    S[16 * (m) + 4 * cc] = t0.x; S[16 * (m) + 4 * cc + 1] = t0.y; S[16 * (m) + 4 * cc + 2] = t1.x; S[16 * (m) + 4 * cc + 3] = t1.y; \
  }
#define LOAD_V(V, base, m) _Pragma("unroll") for (int cc = 0; cc < 4; ++cc) V[cc] = *(const float4*)((base) + 16 * (m) + 4 * cc);
#define LOAD_C(C, vt, m)                         \
  C[0] = *(const float4*)((vt) + 128 + 16 * (m)); \
  C[1] = *(const float4*)((vt) + 192 + 16 * (m));
    __syncthreads();
    for (int i = 0; i <= NT; ++i) {
      if (i < NT) {
        const int b = i & 1;
        const float* ub0 = rec + ((b * 2 + d) * 8) * 384;
        float4 A0[4], A1[4], R0[4], W0[4], W1[4], C0[2], C1[2];
        LOAD_V(A0, ub0 + 64, 0)
        LOAD_V(A1, ub0 + 64, 1)
#pragma unroll 1
        for (int q = 0; q < 8; ++q) {
          const float* ub = ub0 + q * 384;
          const float* vt = ub + l4;
          const float vq = ub[320 + lane];
          fl2_t acc0 = {0.f, 0.f}, acc1 = {0.f, 0.f};
          __builtin_amdgcn_sched_barrier(0);
          LOAD_V(R0, ub + 64, 2)
          DOT_M(acc0, acc1, A0, 0)
          __builtin_amdgcn_sched_barrier(0);
          LOAD_V(A0, ub + 64, 3)
          DOT_M(acc0, acc1, A1, 1)
          __builtin_amdgcn_sched_barrier(0);
          LOAD_C(C0, vt, 0)
          LOAD_V(W0, ub, 0)
          DOT_M(acc0, acc1, R0, 2)
          __builtin_amdgcn_sched_barrier(0);
          LOAD_C(C1, vt, 1)
          LOAD_V(W1, ub, 1)
          LOAD_V(R0, ub + 256, 0)
          DOT_M(acc0, acc1, A0, 3)
          const float sa = (acc0.x + acc0.y) + (acc1.x + acc1.y);
          fl2_t y0 = {0.f, 0.f}, y1 = {0.f, 0.f};
          __builtin_amdgcn_sched_barrier(0);
          MUL_M(W0, 0)
          UPD_M(C0, 0)
          LOAD_C(C0, vt, 2)
          LOAD_V(W0, ub, 2)
          LOAD_V(A1, ub + 256, 1)
          DOT_M(y0, y1, R0, 0)
          __builtin_amdgcn_sched_barrier(0);
          MUL_M(W1, 1)
          UPD_M(C1, 1)
          LOAD_C(C1, vt, 3)
          LOAD_V(W1, ub, 3)
          LOAD_V(R0, ub + 256, 2)
          DOT_M(y0, y1, A1, 1)
          __builtin_amdgcn_sched_barrier(0);
          MUL_M(W0, 2)
          UPD_M(C0, 2)
          LOAD_V(A1, ub + 256, 3)
          DOT_M(y0, y1, R0, 2)
          __builtin_amdgcn_sched_barrier(0);
          MUL_M(W1, 3)
          UPD_M(C1, 3)
          LOAD_V(A0, ub + 384 + 64, 0)
          DOT_M(y0, y1, A1, 3)
          __builtin_amdgcn_sched_barrier(0);
          LOAD_V(A1, ub + 384 + 64, 1)
          yout[((b * 2 + d) * 8 + q) * 64 + lane] = (y0.x + y0.y) + (y1.x + y1.y);
        }
      }
      __syncthreads();
    }
#undef MUL_M
#undef DOT_M
#undef LOAD_V
#undef DPP_FMAC
#undef DPP_MULS
#undef UPD_E
#undef UPD_Q
#undef UPD_M
#undef LOAD_C
    if (s < 32) {
      float* dst = p.out + OFF_RWKV + ((size_t)(((s * 2 + j) * 2 + d) * 64 + hd)) * 4096 + lane * 64;
#pragma unroll
      for (int k = 0; k < 64; k += 4) *(float4*)(dst + k) = float4{S[k], S[k + 1], S[k + 2], S[k + 3]};
    }
  } else {
    const int hi = lane >> 5;
    const int c16 = lane & 15;
    const int qb = ((lane >> 4) & 1) * 4;
    float w0c[2], a0c[2], kkc[2], kac[2], rkc[2];
#pragma unroll
    for (int nbi = 0; nbi < 2; ++nbi) {
      const int e = hd * 64 + (hi * 2 + nbi) * 16 + c16;
      w0c[nbi] = p.w0[(size_t)(j * 2 + d) * EI + e];
      a0c[nbi] = p.a0[(size_t)(j * 2 + d) * EI + e];
      kkc[nbi] = p.k_k[(size_t)j * EI + e];
      kac[nbi] = p.k_a[(size_t)j * EI + e];
      rkc[nbi] = p.r_k[(size_t)j * EI + e];
    }
    const float lnw = p.ln_w[(size_t)j * EI + el];
    const float lnb = p.ln_b[(size_t)j * EI + el];
    const bf16_t* W2 = p.W2T + ((size_t)(j * 2 + d) * EI + hd * 64 + c16) * 128 + (lane >> 4) * 8;
    const bf16_t* A2 = p.A2T + ((size_t)(j * 2 + d) * EI + hd * 64 + c16) * 128 + (lane >> 4) * 8;
    float* BSme = p.BS + (size_t)d * TTOK * 64;
    const float* BSot = p.BS + (size_t)(1 - d) * TTOK * 64;

    auto tile_g = [&](int i, int q) -> size_t {
      return d == 0 ? g0 + (size_t)i * 8 + q : g0 + (size_t)(L - 1 - i * 8 - q);
    };
    bf16x8 xw[4], xa[4];
    unsigned short rr_[2][4], kx_[2][4], vv_[2][4];
    unsigned short ypart[8];
    float bso[8];
    auto prefetch_tile = [&](const int in) {
      const int inc = in < NT ? in : NT - 1;
      const bf16_t* Ap = p.LORA1 + tile_g(inc, lane & 7) * 640 + (lane >> 4) * 8;
#pragma unroll
      for (int ks = 0; ks < 4; ++ks) {
        xw[ks] = *(const bf16x8*)(Ap + d * 128 + ks * 32);
        xa[ks] = *(const bf16x8*)(Ap + 256 + d * 128 + ks * 32);
      }
    };
    auto load_part = [&](const int ip) {
#pragma unroll
      for (int q = 0; q < 8; ++q) {
        const size_t g = tile_g(ip, q);
        ypart[q] = Y[g * EI + el];
        bso[q] = BSot[g * 64 + hd];
      }
    };
    auto prod_iter = [&](const int ip, const int in) {
      const bool do_post = ip >= 0, do_prod = in < NT;
      const bool first = ip < (NT >> 1);
      if (do_post && !first) load_part(ip);
      bf16x8 bwA[4], baA[4];
#define LOAD_B(BW, BA_, ks)                                                  \
  _Pragma("unroll") for (int nb = 0; nb < 4; ++nb) {                         \
    BW[nb] = *(const bf16x8*)(W2 + (size_t)nb * 16 * 128 + (ks) * 32);       \
    BA_[nb] = *(const bf16x8*)(A2 + (size_t)nb * 16 * 128 + (ks) * 32);      \
  }
#define MFMA_B(BW, BA_, ks)                                                  \
  _Pragma("unroll") for (int nb = 0; nb < 4; ++nb) {                         \
    aw[nb] = __builtin_amdgcn_mfma_f32_16x16x32_bf16(xw[ks], BW[nb], aw[nb], 0, 0, 0);  \
    aa[nb] = __builtin_amdgcn_mfma_f32_16x16x32_bf16(xa[ks], BA_[nb], aa[nb], 0, 0, 0); \
  }
      if (do_prod) { LOAD_B(bwA, baA, 0) }
      __builtin_amdgcn_sched_barrier(0);
      if (do_post) {
        const int b = ip & 1;
#pragma unroll
        for (int q = 0; q < 8; ++q) {
          const size_t g = tile_g(ip, q);
          const float y = yout[((b * 2 + d) * 8 + q) * 64 + lane];
          const float bsq = bsl[(b * 2 + d) * 8 + q];
          if (first) {
            Y[g * EI + el] = f2bf(y);
            if (lane == 0) BSme[g * 64 + hd] = bsq;
          } else {
            const float vq = rec[((b * 2 + d) * 8 + q) * 384 + 320 + lane];
            const float yt = y + bf2f(ypart[q]);
            const float mean = wave_sum_fast(yt) * (1.f / 64.f);
            const float dv = yt - mean;
            const float var = wave_sum_fast(dv * dv) * (1.f / 64.f);
            const float yn = dv * __builtin_amdgcn_rsqf(var + 64e-5f) * lnw + lnb;
            Y[g * EI + el] = f2bf(yn + (bsq + bso[q]) * vq);
          }
        }
      }
      __builtin_amdgcn_sched_barrier(0);
      if (do_prod) {
        const int b = in & 1;
        f32x4 aw[4], aa[4];
#pragma unroll
        for (int nb = 0; nb < 4; ++nb) { aw[nb] = f32x4{0.f, 0.f, 0.f, 0.f}; aa[nb] = f32x4{0.f, 0.f, 0.f, 0.f}; }
#pragma unroll
        for (int nbi = 0; nbi < 2; ++nbi)
#pragma unroll
          for (int r = 0; r < 4; ++r) {
            const size_t g = tile_g(in, qb + r);
            const int e = hd * 64 + (hi * 2 + nbi) * 16 + c16;
            rr_[nbi][r] = R[g * EI + e];
            kx_[nbi][r] = Kb[g * EI + e];
            vv_[nbi][r] = V[g * EI + e];
          }
        MFMA_B(bwA, baA, 0)
        __builtin_amdgcn_sched_barrier(0);
        LOAD_B(bwA, baA, 1)
        MFMA_B(bwA, baA, 1)
        __builtin_amdgcn_sched_barrier(0);
        LOAD_B(bwA, baA, 2)
        MFMA_B(bwA, baA, 2)
        __builtin_amdgcn_sched_barrier(0);
        LOAD_B(bwA, baA, 3)
        MFMA_B(bwA, baA, 3)
        float dec[2][4], asg[2][4], kk[2][4], kd[2][4], rr[2][4], vv[2][4], ss[4], bs[4];
#pragma unroll
        for (int r = 0; r < 4; ++r) { ss[r] = 0.f; bs[r] = 0.f; }
#pragma unroll
        for (int nbi = 0; nbi < 2; ++nbi)
#pragma unroll
          for (int r = 0; r < 4; ++r) {
            const float wacc = hi ? aw[2 + nbi][r] : aw[nbi][r];
            const float aacc = hi ? aa[2 + nbi][r] : aa[nbi][r];
            dec[nbi][r] = __expf(-0.6065306597126334f * sigmoidf_(wacc + w0c[nbi]));
            asg[nbi][r] = sigmoidf_(aacc + a0c[nbi]);
            rr[nbi][r] = bf2f(rr_[nbi][r]);
            const float kx = bf2f(kx_[nbi][r]);
            vv[nbi][r] = bf2f(vv_[nbi][r]);
            kk[nbi][r] = kx * kkc[nbi];
            ss[r] += kk[nbi][r] * kk[nbi][r];
            kd[nbi][r] = kx * (1.f + (asg[nbi][r] - 1.f) * kac[nbi]);
            bs[r] += rr[nbi][r] * kd[nbi][r] * rkc[nbi];
          }
        {
          const bool qhi = (lane >> 4) & 1;
#pragma unroll
          for (int r = 0; r < 4; ++r) {
            float a = row_sum16(ss[r]);
            float c = row_sum16(bs[r]);
            float a0 = rdlane(a, 0) + rdlane(a, 32), a1 = rdlane(a, 16) + rdlane(a, 48);
            float c0 = rdlane(c, 0) + rdlane(c, 32), c1 = rdlane(c, 16) + rdlane(c, 48);
            ss[r] = qhi ? a1 : a0;
            bs[r] = qhi ? c1 : c0;
          }
        }
#pragma unroll
        for (int r = 0; r < 4; ++r) {
          const float inv = __builtin_amdgcn_rcpf(fmaxf(__builtin_amdgcn_sqrtf(ss[r]), 1e-12f));
          float* vt = rec + ((b * 2 + d) * 8 + qb + r) * 384;
#pragma unroll
          for (int nbi = 0; nbi < 2; ++nbi) {
            const int ch = (hi * 2 + nbi) * 16 + c16;
            const float kn = kk[nbi][r] * inv;
            vt[ch] = dec[nbi][r];
            vt[64 + ch] = -kn;
            vt[128 + ch] = kn * asg[nbi][r];
            vt[192 + ch] = kd[nbi][r];
            vt[256 + ch] = rr[nbi][r];
            vt[320 + ch] = vv[nbi][r];
          }
          if ((lane & 47) == 0) bsl[(b * 2 + d) * 8 + qb + r] = bs[r];
        }
      }
#undef LOAD_B
#undef MFMA_B
      prefetch_tile(in + 1);
    };
    prefetch_tile(0);
    prod_iter(-1, 0);
    __syncthreads();
    for (int i = 0; i <= NT; ++i) {
      prod_iter(i - 1, i + 1);
      __syncthreads();
    }
  }
  __builtin_amdgcn_s_setprio(0);
  __syncthreads();
}
DEV void phase_rwkv_scan(const int wv, const Params& p, int j, char* smem) {
  const int tid = TID;
  const int G = gridDim.x, b = BID;
  int item, step;
  if (G >= 320) { if (b < 256) { item = b; step = 1 << 20; } else { item = b; step = G - 256; } }
  else { item = b; step = G; }
  for (; item < 2304; item += step) rwkv_item(p, j, item, smem, tid);
  if (G >= 320) {
    if (b >= 256) {
      convert_wt(p.w_g + (size_t)j * DM * EI, DM, EI, p.WB, b - 256, G - 256, smem, tid);
      convert_wt(p.w_o + (size_t)j * EI * DM, EI, DM, p.WB + ((size_t)DM * EI), b - 256, G - 256, smem, tid);
    }
  } else {
    convert_wt(p.w_g + (size_t)j * DM * EI, DM, EI, p.WB, b, G, smem, tid);
    convert_wt(p.w_o + (size_t)j * EI * DM, EI, DM, p.WB + ((size_t)DM * EI), b, G, smem, tid);
  }
}

DEV void fast_barrier(unsigned* bar, const unsigned k) {
  asm volatile("s_waitcnt vmcnt(0)" ::: "memory");
  __syncthreads();
  if (threadIdx.x == 0) {
    __builtin_amdgcn_fence(__ATOMIC_RELEASE, "agent");
    asm volatile("s_waitcnt vmcnt(0)" ::: "memory");
    const unsigned G = gridDim.x;
    const unsigned g = blockIdx.x & 15u;
    const unsigned ng = (G - g + 15u) >> 4;
    const unsigned ngroups = G < 16u ? G : 16u;
    unsigned* grp_cnt = bar + 64 * g;
    unsigned* grp_gen = bar + 64 * (16 + g);
    unsigned* top_cnt = bar + 64 * 32;
    const unsigned old = __hip_atomic_fetch_add(grp_cnt, 1u, __ATOMIC_RELAXED, __HIP_MEMORY_SCOPE_AGENT);
    if (old + 1u == k * ng) {
      const unsigned oldt = __hip_atomic_fetch_add(top_cnt, 1u, __ATOMIC_RELAXED, __HIP_MEMORY_SCOPE_AGENT);
      if (oldt + 1u == k * ngroups) {
        for (unsigned gg = 0; gg < ngroups; ++gg) __hip_atomic_store(bar + 64 * (16 + gg), k, __ATOMIC_RELAXED, __HIP_MEMORY_SCOPE_AGENT);
      }
    }
    unsigned sp = 0;
    while (__hip_atomic_load(grp_gen, __ATOMIC_RELAXED, __HIP_MEMORY_SCOPE_AGENT) < k) {
      __builtin_amdgcn_s_sleep(1);
      if (++sp > (1u << 24)) break;
    }
    __builtin_amdgcn_fence(__ATOMIC_ACQUIRE, "agent");
    asm volatile("s_waitcnt vmcnt(0)" ::: "memory");
  }
  __syncthreads();
}

__global__ void __launch_bounds__(256, 2) mega_kernel(Params p) {
  __shared__ __attribute__((aligned(16))) char smem[69632];
  cg::grid_group grid = cg::this_grid();
  unsigned nbar = 0;
  const int wv = __builtin_amdgcn_readfirstlane((int)(threadIdx.x >> 6));
  phase_prep(wv, p, smem);
  grid.sync();
#pragma unroll 1
  for (int layer = 0; layer < 4; ++layer) {
    phase_row(wv, p, layer, smem);
    fast_barrier(p.BAR, ++nbar);
    const int j = layer >> 1;
    if ((layer & 1) == 0) {
      phase_lru_in(wv, p, j, smem);
      fast_barrier(p.BAR, ++nbar);
      phase_conv(wv, p, j, smem);
      fast_barrier(p.BAR, ++nbar);
      phase_lru_scan(wv, p, j, smem);
      fast_barrier(p.BAR, ++nbar);
      phase_out_proj(wv, p, p.BA, p.WB + ((size_t)DM * EI), (float*)p.BC, smem);
      fast_barrier(p.BAR, ++nbar);
    } else {
      phase_mix(wv, p, j);
      fast_barrier(p.BAR, ++nbar);
      phase_rwkv_ga(wv, p, j, smem);
      fast_barrier(p.BAR, ++nbar);
      if (j == 1) { phase_rwkv_gb(wv, p, smem); fast_barrier(p.BAR, ++nbar); }
      phase_rwkv_gc(wv, p, j, smem);
      fast_barrier(p.BAR, ++nbar);
      phase_rwkv_scan(wv, p, j, smem);
      fast_barrier(p.BAR, ++nbar);
      phase_rwkv_gz(wv, p, j, smem);
      fast_barrier(p.BAR, ++nbar);
      phase_out_proj(wv, p, p.BA, p.WB + ((size_t)DM * EI), (float*)p.BB, smem);
      fast_barrier(p.BAR, ++nbar);
    }
  }
  phase_row(wv, p, 4, smem);
}

extern "C" void kernel_launch(void* const* d_in, const int* in_sizes, int n_in, void* d_out, int out_size, void* d_ws, size_t ws_size,
                              hipStream_t stream) {
  static int grid_blocks = 0;
  if (!grid_blocks) {
    int dev = 0, cus = 0, per_cu = 0;
    hipGetDevice(&dev);
    hipDeviceGetAttribute(&cus, hipDeviceAttributeMultiprocessorCount, dev);
    hipOccupancyMaxActiveBlocksPerMultiprocessor(&per_cu, (const void*)mega_kernel, 256, 0);
    if (per_cu > 2) per_cu = 2;
    if (per_cu < 1) per_cu = 1;
    grid_blocks = cus * per_cu;
  }
  Params p{};
  const float* const* in = (const float* const*)d_in;
  p.x_prompt = in[0]; p.x_sample = in[1]; p.state_lru = in[2]; p.state_rwkv = in[3]; p.c = in[4]; p.c_ctx = in[5];
  p.ada_w = in[6]; p.ada_b = in[7]; p.norm_pre = in[8]; p.norm_post = in[9];
  p.lru_w_in = in[10]; p.lru_conv_w = in[11]; p.lru_conv_b = in[12]; p.lru_gate_w = in[13]; p.lru_gate_b = in[14];
  p.lru_lambda = in[15]; p.lru_w_out = in[16];
  p.mu = in[17]; p.w_r = in[18]; p.w_k = in[19]; p.w_v = in[20]; p.w_g = in[21]; p.w_o = in[22];
  p.w0 = in[23]; p.w1 = in[24]; p.w2 = in[25]; p.a0 = in[26]; p.a1 = in[27]; p.a2 = in[28];
  p.k_k = in[29]; p.k_a = in[30]; p.r_k = in[31]; p.ln_w = in[32]; p.ln_b = in[33]; p.v0 = in[34]; p.v1 = in[35]; p.v2 = in[36];
  p.out = (float*)d_out;
  char* ws = (char*)d_ws;
  size_t off = 0;
  auto take = [&](size_t bytes) { char* r = ws + off; off += (bytes + 255) & ~(size_t)255; return r; };
  p.MOD = (float*)take(4 * 5 * 6144 * 4);
  p.W2T = (bf16_t*)take((size_t)4 * 4096 * 128 * 2);
  p.A2T = (bf16_t*)take((size_t)4 * 4096 * 128 * 2);
  p.H = (bf16_t*)take((size_t)TTOK * DM * 2);
  p.BA = (bf16_t*)take((size_t)TTOK * EI * 2);
  p.BB = (bf16_t*)take((size_t)TTOK * EI * 2);
  p.BC = (bf16_t*)take((size_t)TTOK * EI * 2);
  p.VF = (bf16_t*)take((size_t)TTOK * EI * 2);
  p.LORA1 = (bf16_t*)take((size_t)TTOK * 640 * 2);
  p.BS = (float*)take((size_t)2 * TTOK * 64 * 4);
  p.WB = (bf16_t*)take((size_t)3 * DM * EI * 2);
  p.BAR = (unsigned*)take(16384);
  if (off > ws_size) { fprintf(stderr, "workspace too small: need %zu have %zu\n", off, ws_size); return; }
  hipMemsetAsync(p.BAR, 0, 16384, stream);
  void* args[] = {&p};
  hipError_t e = hipLaunchCooperativeKernel((const void*)mega_kernel, dim3(grid_blocks), dim3(256), args, 0, stream);
  if (e != hipSuccess) fprintf(stderr, "cooperative launch failed: %s (grid %d)\n", hipGetErrorString(e), grid_blocks);
}
```
